# Optimizing an MI355X kernel written in HIP

```python
import jax, jax.numpy as jnp
from jax import lax
import numpy as np

D_MODEL = 1024
BATCH = 8
SEQ = 2048
DEPTH = 2
DEC_BATCH = 128
DEC_SEQ = 1
PAST_LEN = 16384
PAGE_SIZE = 128

N_MEM = 256
D_A = D_MODEL
D_CONF = D_MODEL
D_POOL = D_MODEL
N_POOL_GROUPS = 4
POOL_GROUP = D_POOL // N_POOL_GROUPS
POOL_WINDOWS = (2, 4, 8, 16)
POOL_BUF = max(POOL_WINDOWS) - 1
N_MEM_HEADS = 4
MEM_HEAD_DIM = D_MODEL // N_MEM_HEADS
D_MEM = N_MEM_HEADS * MEM_HEAD_DIM
CONV_A_WIDTH = 3
CONV_B_WIDTH = 31
N_BRANCHES = 4
D_FF = 4 * D_MODEL
PROJ_SIZES = (D_A, D_A, D_A, 2 * D_CONF, D_POOL, D_MEM, N_BRANCHES * D_MODEL)
D_PROJ = D_A * 3 + 2 * D_CONF + D_POOL + D_MEM + N_BRANCHES * D_MODEL
EPS = 1e-6

kernel_name = "hybrid_gated_conv_pool_memattn_decoder_step"


def _split_points():
    pts, acc = [], 0
    for s in PROJ_SIZES[:-1]:
        acc += s
        pts.append(acc)
    return pts


def _rmsnorm(x, g):
    xf = x.astype(jnp.float32)
    y = xf * lax.rsqrt(jnp.mean(xf * xf, axis=-1, keepdims=True) + EPS)
    return (y * g.astype(jnp.float32)).astype(x.dtype)


def _layernorm(x, g, b):
    xf = x.astype(jnp.float32)
    mu = jnp.mean(xf, axis=-1, keepdims=True)
    xc = xf - mu
    var = jnp.mean(xc * xc, axis=-1, keepdims=True)
    y = xc * lax.rsqrt(var + EPS) * g.astype(jnp.float32) + b.astype(jnp.float32)
    return y.astype(x.dtype)


def _causal_dwconv(ext, w):
    return lax.conv_general_dilated(
        ext, w[:, None, :].astype(ext.dtype), window_strides=(1,), padding="VALID",
        dimension_numbers=("NWC", "WIO", "NWC"), feature_group_count=ext.shape[-1])


def _multiscale_pool(ext, start_pos):
    b, n, c = ext.shape
    L = n - POOL_BUF
    cs = jnp.cumsum(ext.astype(jnp.float32), axis=1)
    cs0 = jnp.concatenate([jnp.zeros((b, 1, c), jnp.float32), cs], axis=1)
    pos = start_pos + jnp.arange(L)
    outs = []
    for g, w in enumerate(POOL_WINDOWS):
        lo, hi = g * POOL_GROUP, (g + 1) * POOL_GROUP
        s = cs0[:, POOL_BUF + 1:, lo:hi] - cs0[:, POOL_BUF + 1 - w:POOL_BUF + 1 - w + L, lo:hi]
        cnt = jnp.minimum(pos + 1, w).astype(jnp.float32)[None, :, None]
        outs.append(s / cnt)
    mean = jnp.concatenate(outs, axis=-1)
    return (mean - ext[:, POOL_BUF:].astype(jnp.float32)).astype(ext.dtype)


def _mixing_layer(xn, mem_k, mem_v, buf_a, buf_b, buf_pool, start_pos, w_in, conv_a_w,
                  conv_b_w, conv_b_bias, ln_b_gain, ln_b_bias, pool_w, pool_scale,
                  gate_bias, w_o):
    b, L = xn.shape[0], xn.shape[1]
    proj = jnp.einsum("bsd,de->bse", xn, w_in)
    h_a, b_a, c_a, glu_in, p_in, q, gate_logits = jnp.split(proj, _split_points(), axis=-1)
    ext_a = jnp.concatenate([buf_a, c_a * h_a], axis=1)
    y_a = b_a * _causal_dwconv(ext_a, conv_a_w)
    glu = glu_in[..., :D_CONF] * jax.nn.sigmoid(glu_in[..., D_CONF:])
    ext_b = jnp.concatenate([buf_b, glu], axis=1)
    z = _causal_dwconv(ext_b, conv_b_w) + conv_b_bias
    y_b = jax.nn.silu(_layernorm(z, ln_b_gain, ln_b_bias))
    ext_p = jnp.concatenate([buf_pool, p_in], axis=1)
    pooled = _multiscale_pool(ext_p, start_pos).reshape(b, L, N_POOL_GROUPS, POOL_GROUP)
    y_c = jnp.einsum("bsgc,gcd->bsgd", pooled, pool_w).reshape(b, L, D_POOL) * pool_scale
    qh = q.reshape(b, L, N_MEM_HEADS, MEM_HEAD_DIM)
    s = jnp.einsum("bqhd,bkhd->bhqk", qh, mem_k).astype(jnp.float32) * (MEM_HEAD_DIM ** -0.5)
    pr = jax.nn.softmax(s, axis=-1).astype(mem_v.dtype)
    y_m = jnp.einsum("bhqk,bkhd->bqhd", pr, mem_v).reshape(b, L, D_MEM)
    g = jax.nn.sigmoid(gate_logits + gate_bias).reshape(b, L, N_BRANCHES, D_MODEL)
    merged = g[:, :, 0] * y_a + g[:, :, 1] * y_b + g[:, :, 2] * y_c + g[:, :, 3] * y_m
    out = jnp.einsum("bsd,de->bse", merged, w_o)
    return (out, ext_a[:, -(CONV_A_WIDTH - 1):], ext_b[:, -(CONV_B_WIDTH - 1):],
            ext_p[:, -POOL_BUF:])


def _trunk(x, mem_k, mem_v, buf_a, buf_b, buf_pool, start_pos, norm_mix, w_in, conv_a_w,
           conv_b_w, conv_b_bias, ln_b_gain, ln_b_bias, pool_w, pool_scale, gate_bias, w_o,
           norm_ffn, w_ff1, w_ff2, norm_final):
    new_a, new_b, new_p = [], [], []
    for l in range(DEPTH):
        xn = _rmsnorm(x, norm_mix[l])
        mix, na, nb, npool = _mixing_layer(
            xn, mem_k[l], mem_v[l], buf_a[l], buf_b[l], buf_pool[l], start_pos, w_in[l],
            conv_a_w[l], conv_b_w[l], conv_b_bias[l], ln_b_gain[l], ln_b_bias[l], pool_w[l],
            pool_scale[l], gate_bias[l], w_o[l])
        x = x + mix
        xn = _rmsnorm(x, norm_ffn[l])
        h = jnp.square(jax.nn.relu(jnp.einsum("bsd,df->bsf", xn, w_ff1[l])))
        x = x + jnp.einsum("bsf,fd->bsd", h, w_ff2[l])
        new_a.append(na)
        new_b.append(nb)
        new_p.append(npool)
    return (_rmsnorm(x, norm_final), jnp.stack(new_a), jnp.stack(new_b), jnp.stack(new_p))


def setup_inputs(seed: int = 0) -> dict:
    key = jax.random.key(seed)
    ks = jax.random.split(key, 32)
    f32 = jnp.float32
    nrm = lambda k, shape, scale=1.0: (jax.random.normal(k, shape, f32) * scale)
    gain = lambda k, shape: 1.0 + 0.05 * jax.random.normal(k, shape, f32)
    return {
        "x_prompt": nrm(ks[0], (BATCH, SEQ, D_MODEL)),
        "x_sample": nrm(ks[1], (DEC_BATCH, DEC_SEQ, D_MODEL)),
        "mem_prompt": nrm(ks[2], (BATCH, N_MEM, D_MODEL)),
        "cache_mem_k": nrm(ks[3], (DEPTH, DEC_BATCH, N_MEM, N_MEM_HEADS, MEM_HEAD_DIM)),
        "cache_mem_v": nrm(ks[4], (DEPTH, DEC_BATCH, N_MEM, N_MEM_HEADS, MEM_HEAD_DIM)),
        "state_conv_a": nrm(ks[5], (DEPTH, DEC_BATCH, CONV_A_WIDTH - 1, D_A)),
        "state_conv_b": nrm(ks[6], (DEPTH, DEC_BATCH, CONV_B_WIDTH - 1, D_CONF), 0.5),
        "state_pool": nrm(ks[7], (DEPTH, DEC_BATCH, POOL_BUF, D_POOL)),
        "norm_mix": gain(ks[8], (DEPTH, D_MODEL)),
        "norm_mem": gain(ks[9], (DEPTH, D_MODEL)),
        "w_kv": nrm(ks[10], (DEPTH, D_MODEL, 2 * D_MEM), D_MODEL ** -0.5),
        "w_in": nrm(ks[11], (DEPTH, D_MODEL, D_PROJ), D_MODEL ** -0.5),
        "conv_a_w": nrm(ks[12], (DEPTH, CONV_A_WIDTH, D_A), CONV_A_WIDTH ** -0.5),
        "conv_b_w": nrm(ks[13], (DEPTH, CONV_B_WIDTH, D_CONF), CONV_B_WIDTH ** -0.5),
        "conv_b_bias": nrm(ks[14], (DEPTH, D_CONF), 0.02),
        "ln_b_gain": gain(ks[15], (DEPTH, D_CONF)),
        "ln_b_bias": nrm(ks[16], (DEPTH, D_CONF), 0.02),
        "pool_w": nrm(ks[17], (DEPTH, N_POOL_GROUPS, POOL_GROUP, POOL_GROUP), POOL_GROUP ** -0.5),
        "pool_scale": gain(ks[18], (DEPTH, D_POOL)),
        "gate_bias": nrm(ks[19], (DEPTH, N_BRANCHES * D_MODEL), 0.02),
        "w_o": nrm(ks[20], (DEPTH, D_MODEL, D_MODEL), D_MODEL ** -0.5),
        "norm_ffn": gain(ks[21], (DEPTH, D_MODEL)),
        "w_ff1": nrm(ks[22], (DEPTH, D_MODEL, D_FF), D_MODEL ** -0.5),
        "w_ff2": nrm(ks[23], (DEPTH, D_FF, D_MODEL), D_FF ** -0.5),
        "norm_final": gain(ks[24], (D_MODEL,)),
    }


def reference(x_prompt, x_sample, mem_prompt, cache_mem_k, cache_mem_v, state_conv_a,
              state_conv_b, state_pool, norm_mix, norm_mem, w_kv, w_in, conv_a_w, conv_b_w,
              conv_b_bias, ln_b_gain, ln_b_bias, pool_w, pool_scale, gate_bias, w_o,
              norm_ffn, w_ff1, w_ff2, norm_final):
    dt = x_prompt.dtype
    ks, vs = [], []
    for l in range(DEPTH):
        memn = _rmsnorm(mem_prompt, norm_mem[l])
        kv = jnp.einsum("bmd,de->bme", memn, w_kv[l])
        ks.append(kv[..., :D_MEM].reshape(BATCH, N_MEM, N_MEM_HEADS, MEM_HEAD_DIM))
        vs.append(kv[..., D_MEM:].reshape(BATCH, N_MEM, N_MEM_HEADS, MEM_HEAD_DIM))
    mem_k_prompt = jnp.stack(ks)
    mem_v_prompt = jnp.stack(vs)
    weights = (norm_mix, w_in, conv_a_w, conv_b_w, conv_b_bias, ln_b_gain, ln_b_bias, pool_w,
               pool_scale, gate_bias, w_o, norm_ffn, w_ff1, w_ff2, norm_final)
    zeros_a = jnp.zeros((DEPTH, BATCH, CONV_A_WIDTH - 1, D_A), dt)
    zeros_b = jnp.zeros((DEPTH, BATCH, CONV_B_WIDTH - 1, D_CONF), dt)
    zeros_p = jnp.zeros((DEPTH, BATCH, POOL_BUF, D_POOL), dt)
    y_prompt, conv_a_prompt, conv_b_prompt, pool_prompt = _trunk(
        x_prompt, mem_k_prompt, mem_v_prompt, zeros_a, zeros_b, zeros_p, 0, *weights)
    y_sample, conv_a_sample, conv_b_sample, pool_sample = _trunk(
        x_sample, cache_mem_k, cache_mem_v, state_conv_a, state_conv_b, state_pool, PAST_LEN,
        *weights)
    return (y_prompt, y_sample, mem_k_prompt, mem_v_prompt, conv_a_prompt, conv_b_prompt,
            pool_prompt, conv_a_sample, conv_b_sample, pool_sample)
```

```cpp
#include <hip/hip_runtime.h>
#include <hip/hip_cooperative_groups.h>
#include <cstdio>
#include <cstdint>
namespace cg = cooperative_groups;

#define LAS __attribute__((address_space(3)))
typedef unsigned short bf16_t;
typedef short bf16x8 __attribute__((ext_vector_type(8)));
typedef float f32x4 __attribute__((ext_vector_type(4)));
typedef float f32x2 __attribute__((ext_vector_type(2)));
typedef unsigned u32x4 __attribute__((ext_vector_type(4)));
typedef unsigned u32x2 __attribute__((ext_vector_type(2)));

#define REP_P0 1
#define REP_P2 1
#define REP_P3 1
#define REP_SATT 1
#define REP_P4 1
#define REP_P5 1
#define REP_P7 1
#define REP_SK 1
#define REP_P1 1
#define REP_P6 1
#define REP_P8 1
#define REP_FIN 1
#ifndef USE_CG_SYNC
#define USE_CG_SYNC 0
#endif

constexpr int D = 1024, NBATCH = 8, SEQ = 2048, MP = NBATCH * SEQ, NS = 128, MROWS = MP + NS, MPAD = 16640;
constexpr int NPROJ = 11264, NMEM = 256, DFF = 4096, DEPTH = 2;
constexpr int C_HA = 0, C_BA = 1024, C_CA = 2048, C_G1 = 3072, C_G2 = 4096, C_PIN = 5120, C_Q = 6144, C_GATE = 7168;
constexpr float EPS = 1e-6f;
constexpr size_t OUT_YP = 0, OUT_YS = (size_t)MP * D, OUT_MK = OUT_YS + (size_t)NS * D, OUT_MV = OUT_MK + (size_t)DEPTH * NBATCH * NMEM * D;
constexpr size_t OUT_CAP = OUT_MV + (size_t)DEPTH * NBATCH * NMEM * D, OUT_CBP = OUT_CAP + (size_t)DEPTH * NBATCH * 2 * D, OUT_PPP = OUT_CBP + (size_t)DEPTH * NBATCH * 30 * D;
constexpr size_t OUT_CAS = OUT_PPP + (size_t)DEPTH * NBATCH * 15 * D, OUT_CBS = OUT_CAS + (size_t)DEPTH * NS * 2 * D, OUT_PPS = OUT_CBS + (size_t)DEPTH * NS * 30 * D;
constexpr size_t OUT_END = OUT_PPS + (size_t)DEPTH * NS * 15 * D;
static_assert(OUT_END == 38387712, "output size");
constexpr size_t WS_CTL = 0, CTL_BYTES = 65536;
constexpr size_t WS_WIN = CTL_BYTES;
constexpr size_t WS_WKV = WS_WIN + (size_t)DEPTH * NPROJ * D * 2;
constexpr size_t WS_WO = WS_WKV + (size_t)DEPTH * 2048 * D * 2;
constexpr size_t WS_W1 = WS_WO + (size_t)DEPTH * D * D * 2;
constexpr size_t WS_W2 = WS_W1 + (size_t)DEPTH * DFF * D * 2;
constexpr size_t WS_WP = WS_W2 + (size_t)DEPTH * DFF * D * 2;
constexpr size_t WS_XB = WS_WP + (size_t)DEPTH * 4 * 256 * 256 * 2;
constexpr size_t WS_MEMB = WS_XB + (size_t)MPAD * D * 2;
constexpr size_t WS_KB = WS_MEMB + (size_t)2048 * D * 2;
constexpr size_t WS_VT = WS_KB + (size_t)DEPTH * 2048 * D * 2;
constexpr size_t WS_E = WS_VT + (size_t)DEPTH * 2048 * D * 2;
constexpr size_t WS_PL = WS_E + (size_t)MPAD * D * 2;
constexpr size_t WS_PP = WS_PL + (size_t)MPAD * D * 2;
constexpr size_t WS_MG = WS_PP + (size_t)MP * D * 2;
constexpr size_t WS_X = WS_MG + (size_t)MPAD * D * 2;
constexpr size_t WS_YMS = WS_X + (size_t)MPAD * D * 4;
constexpr size_t WS_RSS = WS_YMS + (size_t)NS * D * 4;
constexpr size_t RSS_BUF = (size_t)MPAD * 16 * 4;
constexpr size_t WS_RSM = WS_RSS + 4 * RSS_BUF;
constexpr size_t WS_RSQ = WS_RSM + 2048 * 4 + 256 * 31;
constexpr size_t WS_PROJ = WS_RSQ + 4 * 128 * 32 * 4;
constexpr size_t WS_END = WS_PROJ + (size_t)MPAD * NPROJ * 2;
static_assert(WS_PROJ % 256 == 0 && WS_XB % 256 == 0 && WS_RSS % 256 == 0, "ws alignment");

constexpr int LDS_BYTES = 147456, LDS_X = 131072;

struct Params {
    const float *x_prompt, *x_sample, *mem_prompt, *cache_k, *cache_v, *st_a, *st_b, *st_p, *norm_mix, *norm_mem, *w_kv, *w_in, *conv_a_w, *conv_b_w, *conv_b_bias,
        *ln_g, *ln_b, *pool_w, *pool_scale, *gate_bias, *w_o, *norm_ffn, *w_ff1, *w_ff2, *norm_final;
    float* out; unsigned char* ws;
};

__device__ __forceinline__ unsigned cvt_pk_bf16(float lo, float hi) { unsigned r; asm("v_cvt_pk_bf16_f32 %0, %1, %2" : "=v"(r) : "v"(lo), "v"(hi)); return r; }
__device__ __forceinline__ float bf_lo(unsigned w) { return __uint_as_float(w << 16); }
__device__ __forceinline__ float bf_hi(unsigned w) { return __uint_as_float(w & 0xffff0000u); }
__device__ __forceinline__ float sigm(float x) { return __builtin_amdgcn_rcpf(1.0f + __builtin_amdgcn_exp2f(-1.44269504f * x)); }
__device__ __forceinline__ int win_src_col(int n) { if (n >= C_PIN) return n; if (n >= C_G1) { const int q = n - C_G1, t = q >> 8, r = q & 255; return r < 128 ? C_G1 + 128 * t + r : C_G2 + 128 * t + (r - 128); } if (n >= 2048) return C_BA + (n - 2048); const int t = n >> 8, r = n & 255; return r < 128 ? C_HA + 128 * t + r : C_CA + 128 * t + (r - 128); }
__device__ __forceinline__ float wave_sum(float v) {
#pragma unroll
    for (int o = 1; o < 64; o <<= 1) v += __shfl_xor(v, o);
    return v;
}
__device__ __forceinline__ float wave_sum_dpp(float v) {
    v += __int_as_float(__builtin_amdgcn_update_dpp(0, __float_as_int(v), 0x128, 0xf, 0xf, false));
    v += __int_as_float(__builtin_amdgcn_update_dpp(0, __float_as_int(v), 0x124, 0xf, 0xf, false));
    v += __int_as_float(__builtin_amdgcn_update_dpp(0, __float_as_int(v), 0x122, 0xf, 0xf, false));
    v += __int_as_float(__builtin_amdgcn_update_dpp(0, __float_as_int(v), 0x121, 0xf, 0xf, false));
    const int iv = __float_as_int(v);
    return (__int_as_float(__builtin_amdgcn_readlane(iv, 0)) + __int_as_float(__builtin_amdgcn_readlane(iv, 16))) + (__int_as_float(__builtin_amdgcn_readlane(iv, 32)) + __int_as_float(__builtin_amdgcn_readlane(iv, 48)));
}
#define LDS_WAIT() asm volatile("s_waitcnt lgkmcnt(0)" ::: "memory")
#define LDS_BARRIER() do { asm volatile("s_waitcnt lgkmcnt(0)" ::: "memory"); __builtin_amdgcn_s_barrier(); asm volatile("" ::: "memory"); } while (0)
__device__ __forceinline__ int fresh_lane() { int l; asm volatile("v_mbcnt_lo_u32_b32 %0, -1, 0\n\tv_mbcnt_hi_u32_b32 %0, -1, %0" : "=v"(l)); return l; }

#define XB_TMO      128
#define XB_XCNT(j)  (256  + 64 * (j))
#define XB_XSUB(j)  (1280 + 64 * (j))
#define XB_XGEN(j)  (2304 + 64 * (j))
#define XB_TOP      3328
#define XB_TOPGEN   3392
#define XCD_BAR_WORDS 3456
#define XB_SPIN_CAP (1u << 22)
__device__ __forceinline__ unsigned xb_ld(unsigned* p)              { return __hip_atomic_load(p, __ATOMIC_RELAXED, __HIP_MEMORY_SCOPE_AGENT); }
__device__ __forceinline__ unsigned xb_add(unsigned* p, unsigned v) { return __hip_atomic_fetch_add(p, v, __ATOMIC_RELAXED, __HIP_MEMORY_SCOPE_AGENT); }
__device__ __forceinline__ unsigned xb_xcc_id() { return (unsigned)__builtin_amdgcn_s_getreg((3 << 11) | 20) & 0xFu; }
#define XB_SPIN(cond, bar) do { unsigned _sp = 0; while (cond) { __builtin_amdgcn_s_sleep(1); \
    if ((++_sp & 255u) == 0u) { if (xb_ld(&(bar)[XB_TMO])) break; if (_sp > XB_SPIN_CAP) { atomicAdd(&(bar)[XB_TMO], 1u); break; } } } } while (0)
struct XcdBarrier { unsigned* bar; unsigned x; volatile LAS unsigned* st; };
__device__ __forceinline__ XcdBarrier xcd_barrier_post(unsigned* bar, volatile LAS unsigned* st) {
    XcdBarrier b; b.bar = bar; b.x = xb_xcc_id(); b.st = st;
    if (threadIdx.x == 0) (void)xb_add(&bar[XB_XCNT(b.x)], 1u);
    return b;
}
__device__ __forceinline__ void xcd_barrier_complete(unsigned* bar, unsigned x, unsigned& nloc, unsigned& nx) {
    const unsigned G = gridDim.x * gridDim.y * gridDim.z;
    unsigned sum, cnt, mine, sp = 0u;
    for (;;) {
        sum = 0u; cnt = 0u; mine = 0u;
#pragma unroll
        for (unsigned j = 0; j < 16; ++j) { const unsigned c = xb_ld(&bar[XB_XCNT(j)]); sum += c; cnt += (c > 0u) ? 1u : 0u; mine = (j == x) ? c : mine; }
        if (sum == G) break;
        __builtin_amdgcn_s_sleep(1);
        if ((++sp & 255u) == 0u) { if (xb_ld(&bar[XB_TMO])) break; if (sp > XB_SPIN_CAP) { atomicAdd(&bar[XB_TMO], 1u); break; } }
    }
    nloc = mine > 0u ? mine : 1u; nx = cnt > 0u ? cnt : 1u;
}
__device__ __forceinline__ void xcd_barrier(const XcdBarrier& b) {
    asm volatile("s_waitcnt vmcnt(0)" ::: "memory");
    __syncthreads();
    if (threadIdx.x == 0) {
        unsigned* bar = b.bar;
        unsigned xid = b.x; asm volatile("" : "+s"(xid));
        __builtin_amdgcn_s_waitcnt(0);
        unsigned nloc = b.st[0], nx = b.st[1];
        if (nloc == 0u) { xcd_barrier_complete(bar, xid, nloc, nx); b.st[0] = nloc; b.st[1] = nx; }
        const unsigned old = xb_add(&bar[XB_XSUB(xid)], 1u);
        const unsigned gen = old / nloc;
        if (old + 1u == (gen + 1u) * nloc) {
            __builtin_amdgcn_fence(__ATOMIC_RELEASE, "agent");
            asm volatile("s_waitcnt vmcnt(0)" ::: "memory");
            const unsigned og = xb_add(&bar[XB_TOP], 1u);
            const unsigned tg = og / nx;
            if (og + 1u == (tg + 1u) * nx) xb_add(&bar[XB_TOPGEN], 1u);
            else XB_SPIN(xb_ld(&bar[XB_TOPGEN]) == tg, bar);
            __builtin_amdgcn_fence(__ATOMIC_ACQUIRE, "agent");
            xb_add(&bar[XB_XGEN(xid)], 1u);
            asm volatile("s_waitcnt vmcnt(0)" ::: "memory");
        } else {
            XB_SPIN(xb_ld(&bar[XB_XGEN(xid)]) == gen, bar);
            __builtin_amdgcn_fence(__ATOMIC_ACQUIRE, "agent");
            asm volatile("s_waitcnt vmcnt(0)" ::: "memory");
        }
    }
    __syncthreads();
}

namespace pg8 {
constexpr int BM = 256, BK = 64, HALF = 128, HTB = HALF * BK * 2, NXCD = 8, WGM = 8;
__host__ __device__ __forceinline__ int lds_byte(int r, int c) { const int st = (r >> 4) * 2 + (c >> 5), rr = r & 15, cc = c & 31, ob = rr * 64 + cc * 2; return st * 1024 + (ob ^ (((ob >> 9) & 1) << 5)); }
__host__ __device__ __forceinline__ void stage_rc(int b, int& R, int& C) { const int st = b / 1024, sb = b % 1024, swz = sb ^ (((sb >> 9) & 1) << 5); R = (st >> 1) * 16 + swz / 64; C = (st & 1) * 32 + (swz % 64) / 2; }
__host__ __device__ __forceinline__ int perm32(int rho) { const int n = rho >> 4, i = rho & 15; return 8 * (i >> 2) + 4 * n + (i & 3); }
struct Unit { int pm, pn, ty; };
struct StaticOrder {
    int nM, nN, nwg, G, c;
    __device__ __forceinline__ void init(int nM_, int nN_, int G_, int c_) { nM = nM_; nN = nN_; nwg = nM * nN; G = G_; c = c_; }
    __device__ __forceinline__ bool next(int i, Unit& u) const {
        const long L = (long)i * G + c; if (L >= nwg) return false;
        int wgid = (int)L; { const int q = nwg / NXCD, r = nwg % NXCD, xcd = wgid % NXCD, off = wgid / NXCD; wgid = (xcd < r ? xcd * (q + 1) : r * (q + 1) + (xcd - r) * q) + off; }
        const int nig = WGM * nN, gid = wgid / nig, fm = gid * WGM, gsz = (nM - fm) < WGM ? (nM - fm) : WGM;
        u.pm = fm + ((wgid % nig) % gsz); u.pn = (wgid % nig) / gsz; u.ty = 0; return true;
    }
};
template <class Prob, class Epi, class Sched>
__device__ __forceinline__ void gemm_phase(LAS unsigned char* lds, const Prob& P, const Sched& S, const Epi& E, const int wave_sgpr) {
    const int wid = wave_sgpr, lane = fresh_lane(), tid = wid * 64 + lane,
        wr = wid >> 2, wc = wid & 3, fr = lane & 15, fq = lane >> 4;
    const int K = P.K, nt = K / BK, lda = P.lda, ldb = P.ldb;
    unsigned voffA[2], voffB[2];
#pragma unroll
    for (int i = 0; i < 2; ++i) { int R, C; stage_rc(tid * 16 + i * 8192, R, C); const int Rb = (R & ~31) + perm32(R & 31);
        voffA[i] = (unsigned)(R * lda + C) * 2u; voffB[i] = (unsigned)(Rb * ldb + C) * 2u; }
    const size_t kstep = (size_t)(BK * 2);
    const size_t hstepA = (size_t)HALF * lda * 2, hstepB = (size_t)HALF * ldb * 2;
    const unsigned ldsw = (unsigned)wid * 1024u;
    const int aoff = lds_byte(wr * 64 + fr, fq * 8), boff = lds_byte(wc * 32 + fr, fq * 8);
#define PG8_SA(b, h) (((b) * 2 + (h)) * HTB)
#define PG8_SB(b, h) ((4 + (b) * 2 + (h)) * HTB)
#define PG8_STAGE(bufoff, gbase, voff) do { _Pragma("unroll") for (int _i = 0; _i < 2; ++_i) \
        __builtin_amdgcn_global_load_lds((const unsigned*)((const char*)(gbase) + (voff)[_i]), (LAS unsigned*)(lds + (bufoff) + ldsw + _i * 8192), 16, 0, 0); } while (0)
#define PG8_LDA(dst, b, h) do { _Pragma("unroll") for (int m = 0; m < 4; ++m) _Pragma("unroll") for (int k = 0; k < 2; ++k) dst[m][k] = *(const LAS bf16x8*)(lds + PG8_SA(b, h) + aoff + m * 2048 + k * 1024); } while (0)
#define PG8_LDB(dst, b, h) do { _Pragma("unroll") for (int n = 0; n < 2; ++n) _Pragma("unroll") for (int k = 0; k < 2; ++k) dst[n][k] = *(const LAS bf16x8*)(lds + PG8_SB(b, h) + boff + n * 2048 + k * 1024); } while (0)
#define PG8_MMA(ai, bj, At, Bt) do { __builtin_amdgcn_s_setprio(1); _Pragma("unroll") for (int m = 0; m < 4; ++m) _Pragma("unroll") for (int n = 0; n < 2; ++n) _Pragma("unroll") for (int k = 0; k < 2; ++k) \
        acc[ai][bj][m][n] = __builtin_amdgcn_mfma_f32_16x16x32_bf16(Bt[n][k], At[m][k], acc[ai][bj][m][n], 0, 0, 0); __builtin_amdgcn_s_setprio(0); } while (0)
#define PG8_WAIT_V(n) asm volatile("s_waitcnt vmcnt(" #n ")" ::: "memory")
#define PG8_WAIT_L(n) asm volatile("s_waitcnt lgkmcnt(" #n ")" ::: "memory")
#define PG8_BAR __builtin_amdgcn_s_barrier()
#define PG8_SCHED __builtin_amdgcn_sched_barrier(0)
    Unit cur, nxt; int ui = 0;
    if (!S.next(0, cur)) return;
    f32x4 acc[2][2][4][2];
#pragma unroll
    for (int a = 0; a < 2; ++a)
#pragma unroll
        for (int b = 0; b < 2; ++b)
#pragma unroll
            for (int m = 0; m < 4; ++m)
#pragma unroll
                for (int n = 0; n < 2; ++n) acc[a][b][m][n] = (f32x4){0.f, 0.f, 0.f, 0.f};
    bf16x8 At[4][2], B0[2][2], B1[2][2];
    const char* cA = P.a_base(cur); const char* cB = P.b_base(cur);
    int tbuf = 0;
    if constexpr (Epi::USES_RSTD) { if (tid < 256) {
        const f32x4* q = (const f32x4*)(E.rss + (size_t)(cur.pm * 256 + tid) * 16); const f32x4 t0 = q[0], t1 = q[1], t2 = q[2], t3 = q[3];
        ((LAS float*)(lds + LDS_X + 9216))[tid] = rsqrtf((((t0.x + t0.y) + (t0.z + t0.w)) + ((t1.x + t1.y) + (t1.z + t1.w)) + ((t2.x + t2.y) + (t2.z + t2.w)) + ((t3.x + t3.y) + (t3.z + t3.w))) * (1.0f / D) + EPS); } }
    PG8_STAGE(PG8_SB(0, 0), cB, voffB); PG8_STAGE(PG8_SB(0, 1), cB + hstepB, voffB); PG8_STAGE(PG8_SA(0, 0), cA, voffA); PG8_STAGE(PG8_SA(0, 1), cA + hstepA, voffA);
    if (wr == 1) PG8_BAR;
    PG8_WAIT_V(2); PG8_BAR;
    PG8_STAGE(PG8_SB(1, 0), cB + kstep, voffB); PG8_STAGE(PG8_SA(1, 0), cA + kstep, voffA); PG8_STAGE(PG8_SB(1, 1), cB + hstepB + kstep, voffB);
    PG8_WAIT_V(6); PG8_BAR;
    for (;;) {
        const bool has_next = S.next(ui + 1, nxt);
        const char* nA = has_next ? P.a_base(nxt) : cA; const char* nB = has_next ? P.b_base(nxt) : cB;
        for (int t = 0; t < nt; t += 2) {
            const bool last = (t == nt - 2);
            const char* a1 = cA + (size_t)(t + 1) * kstep;
            const char* a2 = last ? nA : cA + (size_t)(t + 2) * kstep; const char* b2 = last ? nB : cB + (size_t)(t + 2) * kstep;
            const char* a3 = a2 + kstep; const char* b3 = b2 + kstep;
            PG8_LDB(B0, 0, 0); PG8_LDB(B1, 0, 1); PG8_SCHED; PG8_LDA(At, 0, 0); PG8_STAGE(PG8_SA(1, 1), a1 + hstepA, voffA);
            PG8_WAIT_V(8); PG8_WAIT_L(0); PG8_BAR; PG8_MMA(0, 0, At, B0); PG8_MMA(0, 1, At, B1); PG8_BAR; PG8_SCHED;
            PG8_LDA(At, 0, 1); PG8_STAGE(PG8_SB(0, 0), b2, voffB); PG8_STAGE(PG8_SB(0, 1), b2 + hstepB, voffB); PG8_STAGE(PG8_SA(0, 0), a2, voffA);
            PG8_WAIT_V(8); PG8_WAIT_L(0); PG8_BAR; PG8_MMA(1, 0, At, B0); PG8_MMA(1, 1, At, B1); PG8_BAR; PG8_SCHED;
            PG8_LDB(B0, 1, 0); PG8_LDB(B1, 1, 1); PG8_SCHED; PG8_LDA(At, 1, 0); PG8_STAGE(PG8_SA(0, 1), a2 + hstepA, voffA);
            PG8_WAIT_V(8); PG8_WAIT_L(0); PG8_BAR; PG8_MMA(0, 0, At, B0); PG8_MMA(0, 1, At, B1); PG8_BAR; PG8_SCHED;
            PG8_LDA(At, 1, 1); PG8_STAGE(PG8_SB(1, 0), b3, voffB); PG8_STAGE(PG8_SB(1, 1), b3 + hstepB, voffB); PG8_STAGE(PG8_SA(1, 0), a3, voffA);
            PG8_WAIT_V(8); PG8_WAIT_L(0); PG8_BAR; PG8_MMA(1, 0, At, B0); PG8_MMA(1, 1, At, B1); PG8_BAR; PG8_SCHED;
        }
        if (wr == 0) PG8_BAR;
        f32x4 nx0, nx1, nx2, nx3;
        if constexpr (Epi::USES_RSTD) { if (has_next && tid < 256) { const f32x4* q = (const f32x4*)(E.rss + (size_t)(nxt.pm * 256 + tid) * 16); nx0 = q[0]; nx1 = q[1]; nx2 = q[2]; nx3 = q[3]; } }
        E(acc, cur, wr, wc, fr, fq, lds, tbuf);
        if constexpr (Epi::USES_RSTD) { if (has_next && tid < 256)
            ((LAS float*)(lds + LDS_X + 9216))[(tbuf ^ 1) * 256 + tid] = rsqrtf((((nx0.x + nx0.y) + (nx0.z + nx0.w)) + ((nx1.x + nx1.y) + (nx1.z + nx1.w)) + ((nx2.x + nx2.y) + (nx2.z + nx2.w)) + ((nx3.x + nx3.y) + (nx3.z + nx3.w))) * (1.0f / D) + EPS);
            tbuf ^= 1; }
        if (!has_next) break;
#pragma unroll
        for (int a = 0; a < 2; ++a)
#pragma unroll
            for (int b = 0; b < 2; ++b)
#pragma unroll
                for (int m = 0; m < 4; ++m)
#pragma unroll
                    for (int n = 0; n < 2; ++n) acc[a][b][m][n] = (f32x4){0.f, 0.f, 0.f, 0.f};
        cur = nxt; cA = nA; cB = nB; ++ui;
        if (wr == 1) PG8_BAR;
    }
    PG8_WAIT_V(0);
    PG8_BAR;
#undef PG8_SA
#undef PG8_SB
#undef PG8_STAGE
#undef PG8_LDA
#undef PG8_LDB
#undef PG8_MMA
#undef PG8_WAIT_V
#undef PG8_WAIT_L
#undef PG8_BAR
#undef PG8_SCHED
}
}
using pg8::Unit;
typedef f32x4 Acc[2][2][4][2];

struct ProbStd { const char* A; const char* B; int lda, ldb, K;
    __device__ __forceinline__ const char* a_base(const Unit& u) const { return A + (size_t)u.pm * 256 * lda * 2; }
    __device__ __forceinline__ const char* b_base(const Unit& u) const { return B + (size_t)u.pn * 256 * ldb * 2; } };
struct ProbS { const char* PROJ; const char* KB; int lda, ldb, K;
    __device__ __forceinline__ const char* a_base(const Unit& u) const { return PROJ + ((size_t)u.pm * 256 * NPROJ + C_Q + u.pn * 256) * 2; }
    __device__ __forceinline__ const char* b_base(const Unit& u) const { return KB + ((size_t)((u.pm >> 3) * 256) * D + u.pn * 256) * 2; } };
struct ProbMerge { const char* PL; const char* WP; long dA, dB; int lda, ldb, K;
    __device__ __forceinline__ const char* a_base(const Unit& u) const { return PL + (long)u.ty * dA + ((size_t)u.pm * 256 * D + u.pn * 256) * 2; }
    __device__ __forceinline__ const char* b_base(const Unit& u) const { return WP + (long)u.ty * dB + (size_t)(u.ty * (u.pm >> 3) * 4 + u.pn) * 65536 * 2; } };
struct OrderS { int G, c;
    __device__ __forceinline__ bool next(int i, Unit& u) const { const int L = i * G + c; if (L >= 256) return false; u.pm = L >> 2; u.pn = L & 3; u.ty = 0; return true; } };
struct OrderMerge { int G, c;
    __device__ __forceinline__ bool next(int i, Unit& u) const {
        const int k = i >> 1, sub = i & 1, T = k * G + c; if (T >= 256) return false;
        u.pm = T >> 2; u.pn = T & 3; u.ty = sub; return true; } };

__device__ __forceinline__ void row_rstd8(const float* rss, int rowbase, int fq, float (&rs)[2][4]) {
    f32x4 t[2][4];
#pragma unroll
    for (int ai = 0; ai < 2; ++ai)
#pragma unroll
        for (int m = 0; m < 4; ++m) t[ai][m] = *(const f32x4*)(rss + (size_t)(rowbase + ai * 128 + m * 16) * 16 + fq * 4);
#pragma unroll
    for (int ai = 0; ai < 2; ++ai)
#pragma unroll
        for (int m = 0; m < 4; ++m) { float s = (t[ai][m].x + t[ai][m].y) + (t[ai][m].z + t[ai][m].w); s += __shfl_xor(s, 16); s += __shfl_xor(s, 32); rs[ai][m] = rsqrtf(s * (1.0f / D) + EPS); }
}
struct EpiKV {
    static constexpr bool USES_RSTD = false; static constexpr const float* rss = nullptr;
    float* out; bf16_t* KB; bf16_t* VT; const float* rsm;
    __device__ __forceinline__ void operator()(Acc& acc, const Unit& u, int wr, int wc, int fr, int fq, LAS unsigned char*, int) const {
        const int l = u.pn >> 3, pnl = u.pn & 7, isV = pnl >> 2, hh = pnl & 3;
        const int row0 = u.pm * 256 + wr * 64 + fr, cl0 = wc * 32 + 8 * fq;
        float* ob = out + (isV ? OUT_MV : OUT_MK) + (size_t)l * 2048 * D;
#pragma unroll
        for (int ai = 0; ai < 2; ++ai)
#pragma unroll
            for (int m = 0; m < 4; ++m) { const int row = row0 + ai * 128 + m * 16; const float rs = rsqrtf(rsm[row] * (1.0f / D) + EPS);
#pragma unroll
                for (int bj = 0; bj < 2; ++bj) { const int dcol = bj * 128 + cl0, ck = hh * 256 + dcol; const f32x4 v0 = acc[ai][bj][m][0] * rs, v1 = acc[ai][bj][m][1] * rs;
                    float* op = ob + (size_t)row * D + ck; *(f32x4*)op = v0; *(f32x4*)(op + 4) = v1;
                    if (!isV) { u32x4 w; w.x = cvt_pk_bf16(v0[0], v0[1]); w.y = cvt_pk_bf16(v0[2], v0[3]); w.z = cvt_pk_bf16(v1[0], v1[1]); w.w = cvt_pk_bf16(v1[2], v1[3]);
                        *(u32x4*)(KB + ((size_t)l * 2048 + row) * D + ck) = w; }
                    else { bf16_t* vp = VT + ((size_t)((l * 8 + (row >> 8)) * 4 + hh) * 256 + dcol) * 256 + (row & 255);
#pragma unroll
                        for (int e = 0; e < 4; ++e) { vp[(size_t)e * 256] = (bf16_t)(cvt_pk_bf16(v0[e], 0.f) & 0xffffu); vp[(size_t)(e + 4) * 256] = (bf16_t)(cvt_pk_bf16(v1[e], 0.f) & 0xffffu); } } } }
    }
};
struct EpiProj {
    static constexpr bool USES_RSTD = true; bf16_t* O; int ldc; const float* rss;
    __device__ __forceinline__ void operator()(Acc& acc, const Unit& u, int wr, int wc, int fr, int fq, LAS unsigned char* lds, int tbuf) const {
        const int row0 = u.pm * 256 + wr * 64 + fr, col0 = u.pn * 256 + wc * 32 + 8 * fq;
        const LAS float* T = (const LAS float*)(lds + LDS_X + 9216) + tbuf * 256 + wr * 64 + fr;
        const int dcol0 = win_src_col(u.pn * 256) + wc * 32 + 8 * fq;
        if (u.pn < 8) {
            const int ucol = C_HA + u.pn * 128 + wc * 32 + 8 * fq;
#pragma unroll
            for (int ai = 0; ai < 2; ++ai)
#pragma unroll
                for (int m = 0; m < 4; ++m) { const float r = T[ai * 128 + m * 16], r2 = r * r;
                    const f32x4 p0 = acc[ai][0][m][0] * acc[ai][1][m][0] * r2, p1 = acc[ai][0][m][1] * acc[ai][1][m][1] * r2;
                    u32x4 w; w.x = cvt_pk_bf16(p0[0], p0[1]); w.y = cvt_pk_bf16(p0[2], p0[3]); w.z = cvt_pk_bf16(p1[0], p1[1]); w.w = cvt_pk_bf16(p1[2], p1[3]);
                    __builtin_nontemporal_store(w, (u32x4*)(O + (size_t)(row0 + ai * 128 + m * 16) * ldc + ucol)); }
            return; }
        if (u.pn >= 12 && u.pn < 20) {
            const int gcol = C_G1 + (u.pn - 12) * 128 + wc * 32 + 8 * fq;
#pragma unroll
            for (int ai = 0; ai < 2; ++ai)
#pragma unroll
                for (int m = 0; m < 4; ++m) { const float r = T[ai * 128 + m * 16];
                    const f32x4 a0 = acc[ai][0][m][0] * r, a1 = acc[ai][0][m][1] * r, b0 = acc[ai][1][m][0] * r, b1 = acc[ai][1][m][1] * r;
                    u32x4 w; w.x = cvt_pk_bf16(a0[0] * sigm(b0[0]), a0[1] * sigm(b0[1])); w.y = cvt_pk_bf16(a0[2] * sigm(b0[2]), a0[3] * sigm(b0[3]));
                    w.z = cvt_pk_bf16(a1[0] * sigm(b1[0]), a1[1] * sigm(b1[1])); w.w = cvt_pk_bf16(a1[2] * sigm(b1[2]), a1[3] * sigm(b1[3]));
                    __builtin_nontemporal_store(w, (u32x4*)(O + (size_t)(row0 + ai * 128 + m * 16) * ldc + gcol)); }
            return; }
#pragma unroll
        for (int ai = 0; ai < 2; ++ai)
#pragma unroll
            for (int m = 0; m < 4; ++m) { bf16_t* rowp = O + (size_t)(row0 + ai * 128 + m * 16) * ldc + dcol0; const float r = T[ai * 128 + m * 16];
#pragma unroll
                for (int bj = 0; bj < 2; ++bj) { const f32x4 v0 = acc[ai][bj][m][0] * r, v1 = acc[ai][bj][m][1] * r;
                    u32x4 w; w.x = cvt_pk_bf16(v0[0], v0[1]); w.y = cvt_pk_bf16(v0[2], v0[3]); w.z = cvt_pk_bf16(v1[0], v1[1]); w.w = cvt_pk_bf16(v1[2], v1[3]);
                    __builtin_nontemporal_store(w, (u32x4*)(rowp + bj * 128)); } }
    }
};
struct EpiFF1 {
    static constexpr bool USES_RSTD = true; bf16_t* O; const float* rss;
    __device__ __forceinline__ void operator()(Acc& acc, const Unit& u, int wr, int wc, int fr, int fq, LAS unsigned char* lds, int tbuf) const {
        const int row0 = u.pm * 256 + wr * 64 + fr, col0 = u.pn * 256 + wc * 32 + 8 * fq;
        const LAS float* T = (const LAS float*)(lds + LDS_X + 9216) + tbuf * 256 + wr * 64 + fr;
#pragma unroll
        for (int ai = 0; ai < 2; ++ai)
#pragma unroll
            for (int m = 0; m < 4; ++m) { bf16_t* rowp = O + (size_t)(row0 + ai * 128 + m * 16) * DFF + col0; const float r = T[ai * 128 + m * 16];
#pragma unroll
                for (int bj = 0; bj < 2; ++bj) { f32x4 v0 = acc[ai][bj][m][0] * r, v1 = acc[ai][bj][m][1] * r;
#pragma unroll
                    for (int e = 0; e < 4; ++e) { const float a = fmaxf(v0[e], 0.f), b = fmaxf(v1[e], 0.f); v0[e] = a * a; v1[e] = b * b; }
                    u32x4 w; w.x = cvt_pk_bf16(v0[0], v0[1]); w.y = cvt_pk_bf16(v0[2], v0[3]); w.z = cvt_pk_bf16(v1[0], v1[1]); w.w = cvt_pk_bf16(v1[2], v1[3]);
                    *(u32x4*)(rowp + bj * 128) = w; } }
    }
};
struct EpiRes {
    static constexpr bool USES_RSTD = false;
    const float* xin_p; bf16_t* XB; float* rss;
    __device__ __forceinline__ void operator()(Acc& acc, const Unit& u, int wr, int wc, int fr, int fq, LAS unsigned char*, int) const {
        const int row0 = u.pm * 256 + wr * 64 + fr, col0 = u.pn * 256 + wc * 32 + 8 * fq;
#pragma unroll
        for (int ai = 0; ai < 2; ++ai) {
            f32x4 r[4][2][2];
            if (xin_p) {
#pragma unroll
                for (int m = 0; m < 4; ++m)
#pragma unroll
                    for (int bj = 0; bj < 2; ++bj) { const float* sp = xin_p + (size_t)(row0 + ai * 128 + m * 16) * D + col0 + bj * 128; r[m][bj][0] = *(const f32x4*)sp; r[m][bj][1] = *(const f32x4*)(sp + 4); }
            } else {
                u32x4 rb[4][2];
#pragma unroll
                for (int m = 0; m < 4; ++m)
#pragma unroll
                    for (int bj = 0; bj < 2; ++bj) rb[m][bj] = *(const u32x4*)(XB + (size_t)(row0 + ai * 128 + m * 16) * D + col0 + bj * 128);
#pragma unroll
                for (int m = 0; m < 4; ++m)
#pragma unroll
                    for (int bj = 0; bj < 2; ++bj) { const u32x4 q = rb[m][bj]; r[m][bj][0] = (f32x4){bf_lo(q.x), bf_hi(q.x), bf_lo(q.y), bf_hi(q.y)}; r[m][bj][1] = (f32x4){bf_lo(q.z), bf_hi(q.z), bf_lo(q.w), bf_hi(q.w)}; }
            }
#pragma unroll
            for (int m = 0; m < 4; ++m) { const int row = row0 + ai * 128 + m * 16; float ss = 0.f;
#pragma unroll
                for (int bj = 0; bj < 2; ++bj) { const int col = col0 + bj * 128;
                    const f32x4 v0 = r[m][bj][0] + acc[ai][bj][m][0], v1 = r[m][bj][1] + acc[ai][bj][m][1];
                    u32x4 w; w.x = cvt_pk_bf16(v0[0], v0[1]); w.y = cvt_pk_bf16(v0[2], v0[3]); w.z = cvt_pk_bf16(v1[0], v1[1]); w.w = cvt_pk_bf16(v1[2], v1[3]);
                    *(u32x4*)(XB + (size_t)row * D + col) = w;
                    ss += (v0[0] * v0[0] + v0[1] * v0[1]) + (v0[2] * v0[2] + v0[3] * v0[3]) + (v1[0] * v1[0] + v1[1] * v1[1]) + (v1[2] * v1[2] + v1[3] * v1[3]); }
                ss += __shfl_xor(ss, 16); ss += __shfl_xor(ss, 32);
                if (fq == 0) rss[(size_t)row * 16 + u.pn * 4 + wc] = ss; }
        }
    }
};
struct EpiS {
    static constexpr bool USES_RSTD = false; static constexpr const float* rss = nullptr;
    bf16_t* PP;
    __device__ __forceinline__ void operator()(Acc& acc, const Unit& u, int wr, int wc, int fr, int fq, LAS unsigned char* lds, int tbuf) const {
        LAS float* TM = (LAS float*)(lds + LDS_X); LAS float* TS = (LAS float*)(lds + LDS_X + 4096);
        const float sc = 0.0625f * 1.44269504f;
#pragma unroll
        for (int ai = 0; ai < 2; ++ai)
#pragma unroll
            for (int m = 0; m < 4; ++m) { float v = -3.0e38f;
#pragma unroll
                for (int bj = 0; bj < 2; ++bj)
#pragma unroll
                    for (int n = 0; n < 2; ++n) { const f32x4 x = acc[ai][bj][m][n]; v = fmaxf(v, fmaxf(fmaxf(x[0], x[1]), fmaxf(x[2], x[3]))); }
                v = fmaxf(v, __shfl_xor(v, 16)); v = fmaxf(v, __shfl_xor(v, 32));
                if (fq == 0) TM[(ai * 128 + wr * 64 + m * 16 + fr) * 4 + wc] = v; }
        LDS_WAIT(); __builtin_amdgcn_s_barrier(); asm volatile("" ::: "memory");
#pragma unroll
        for (int ai = 0; ai < 2; ++ai)
#pragma unroll
            for (int m = 0; m < 4; ++m) { const int rl = ai * 128 + wr * 64 + m * 16 + fr; const f32x4 t = *(const LAS f32x4*)(TM + rl * 4);
                const float gm = fmaxf(fmaxf(t[0], t[1]), fmaxf(t[2], t[3])) * sc; float s = 0.f;
#pragma unroll
                for (int bj = 0; bj < 2; ++bj)
#pragma unroll
                    for (int n = 0; n < 2; ++n) { f32x4 x = acc[ai][bj][m][n];
#pragma unroll
                        for (int e = 0; e < 4; ++e) { x[e] = __builtin_amdgcn_exp2f(x[e] * sc - gm); s += x[e]; }
                        acc[ai][bj][m][n] = x; }
                s += __shfl_xor(s, 16); s += __shfl_xor(s, 32);
                if (fq == 0) TS[rl * 4 + wc] = s; }
        LDS_WAIT(); __builtin_amdgcn_s_barrier(); asm volatile("" ::: "memory");
        const int row0 = u.pm * 256 + wr * 64 + fr, col0 = u.pn * 256 + wc * 32 + 8 * fq;
#pragma unroll
        for (int ai = 0; ai < 2; ++ai)
#pragma unroll
            for (int m = 0; m < 4; ++m) { const int rl = ai * 128 + wr * 64 + m * 16 + fr; const f32x4 t = *(const LAS f32x4*)(TS + rl * 4);
                const float inv = 1.0f / ((t[0] + t[1]) + (t[2] + t[3])); bf16_t* rowp = PP + (size_t)(row0 + ai * 128 + m * 16) * D + col0;
#pragma unroll
                for (int bj = 0; bj < 2; ++bj) { const f32x4 v0 = acc[ai][bj][m][0] * inv, v1 = acc[ai][bj][m][1] * inv;
                    u32x4 w; w.x = cvt_pk_bf16(v0[0], v0[1]); w.y = cvt_pk_bf16(v0[2], v0[3]); w.z = cvt_pk_bf16(v1[0], v1[1]); w.w = cvt_pk_bf16(v1[2], v1[3]);
                    *(u32x4*)(rowp + bj * 128) = w; } }
    }
};
struct EpiMerge {
    static constexpr bool USES_RSTD = false; static constexpr const float* rss = nullptr;
    const bf16_t* E; bf16_t* MG; const bf16_t* PROJ; const float* gbias;
    __device__ __forceinline__ void operator()(Acc& acc, const Unit& u, int wr, int wc, int fr, int fq, LAS unsigned char*, int) const {
        const int row0 = u.pm * 256 + wr * 64 + fr, col0 = u.pn * 256 + wc * 32 + 8 * fq;
        const int gsel = 2 + u.ty;
        const bf16_t* bsrc = E + (long)u.ty * (long)((const bf16_t*)MG - E);
        f32x4 gb[2][2];
#pragma unroll
        for (int bj = 0; bj < 2; ++bj) { gb[bj][0] = *(const f32x4*)(gbias + gsel * D + col0 + bj * 128); gb[bj][1] = *(const f32x4*)(gbias + gsel * D + col0 + bj * 128 + 4); }
#pragma unroll
        for (int ai = 0; ai < 2; ++ai) {
            u32x4 bs[4][2], gl[4][2];
#pragma unroll
            for (int m = 0; m < 4; ++m)
#pragma unroll
                for (int bj = 0; bj < 2; ++bj) { const size_t row = (size_t)(row0 + ai * 128 + m * 16); const int col = col0 + bj * 128;
                    bs[m][bj] = *(const u32x4*)(bsrc + row * D + col); gl[m][bj] = __builtin_nontemporal_load((const u32x4*)(PROJ + row * NPROJ + C_GATE + gsel * D + col)); }
#pragma unroll
            for (int m = 0; m < 4; ++m)
#pragma unroll
                for (int bj = 0; bj < 2; ++bj) { const size_t row = (size_t)(row0 + ai * 128 + m * 16); const int col = col0 + bj * 128;
                    const u32x4 base = bs[m][bj], g = gl[m][bj]; const f32x4 gb0 = gb[bj][0], gb1 = gb[bj][1], a0 = acc[ai][bj][m][0], a1 = acc[ai][bj][m][1];
                    float o[8];
                    o[0] = bf_lo(base.x) + sigm(bf_lo(g.x) + gb0[0]) * a0[0]; o[1] = bf_hi(base.x) + sigm(bf_hi(g.x) + gb0[1]) * a0[1];
                    o[2] = bf_lo(base.y) + sigm(bf_lo(g.y) + gb0[2]) * a0[2]; o[3] = bf_hi(base.y) + sigm(bf_hi(g.y) + gb0[3]) * a0[3];
                    o[4] = bf_lo(base.z) + sigm(bf_lo(g.z) + gb1[0]) * a1[0]; o[5] = bf_hi(base.z) + sigm(bf_hi(g.z) + gb1[1]) * a1[1];
                    o[6] = bf_lo(base.w) + sigm(bf_lo(g.w) + gb1[2]) * a1[2]; o[7] = bf_hi(base.w) + sigm(bf_hi(g.w) + gb1[3]) * a1[3];
                    u32x4 w; w.x = cvt_pk_bf16(o[0], o[1]); w.y = cvt_pk_bf16(o[2], o[3]); w.z = cvt_pk_bf16(o[4], o[5]); w.w = cvt_pk_bf16(o[6], o[7]);
                    *(u32x4*)(MG + row * D + col) = w; }
        }
    }
};

template <int CH> __device__ __forceinline__ void sk_load(const bf16_t* Ab, const bf16_t* Bb, int lda, int ldb, bf16x8 (&a)[2][CH], bf16x8 (&b)[2][CH]) {
#pragma unroll
    for (int q = 0; q < CH; ++q) { a[0][q] = *(const bf16x8*)(Ab + q * 32); a[1][q] = *(const bf16x8*)(Ab + (size_t)16 * lda + q * 32);
        b[0][q] = *(const bf16x8*)(Bb + q * 32); b[1][q] = *(const bf16x8*)(Bb + (size_t)16 * ldb + q * 32); }
}
template <int KSTEPS, class SP, class SE>
__device__ __forceinline__ void skinny_gemm(LAS unsigned char* lds, const SP& P, const SE& E, int ntasks, int bxo, int Go, int wid, int tbase = 0) {
    constexpr int CH = KSTEPS < 4 ? KSTEPS : 4, NCH = KSTEPS / CH, KW = KSTEPS * 32;
    const int lane = fresh_lane(), fr = lane & 15, fq = lane >> 4, tid = wid * 64 + lane;
    LAS float* RB = (LAS float*)lds;
    LAS float* PSS = RB + 8 * 16 * 64;
    const int lda = P.lda, ldb = P.ldb;
    const int nmy = bxo < ntasks ? (ntasks - bxo + Go - 1) / Go : 0, nchunks = nmy * NCH;
    if (nchunks == 0) return;
    bf16x8 a[2][CH], b[2][CH], an[2][CH], bn[2][CH];
    { const int t = tbase + bxo, rt = t & 3, ct = t >> 2;
      sk_load<CH>(P.a_ptr(ct) + (size_t)(rt * 32 + fr) * lda + wid * KW + fq * 8, P.b_ptr(ct) + (size_t)fr * ldb + wid * KW + fq * 8, lda, ldb, a, b); }
    f32x4 acc[2][2];
    asm volatile("s_waitcnt vmcnt(0)" ::: "memory");
    int prt = -1; typename SE::RowPre rowpre = {};
#pragma unroll 1
    for (int c = 0; c < nchunks; ++c) {
        const int ti = c / NCH, ch = c % NCH, t = tbase + bxo + ti * Go, rt = t & 3, ct = t >> 2;
        const int erow = rt * 32 + (wid >> 1) * 16 + fr, ecol = ct * 32 + (wid & 1) * 16 + 4 * fq;
        if (wid < 4 && rt != prt) { rowpre = E.prep_row(erow); prt = rt; }
        typename SE::Pre pre;
        if (ch == NCH - 1 && wid < 4) pre = E.prep(erow, ecol);
        if (c + 1 < nchunks) { const int c1 = c + 1, t1 = tbase + bxo + (c1 / NCH) * Go, ch1 = c1 % NCH, rt1 = t1 & 3, ct1 = t1 >> 2;
            sk_load<CH>(P.a_ptr(ct1) + (size_t)(rt1 * 32 + fr) * lda + wid * KW + ch1 * (CH * 32) + fq * 8, P.b_ptr(ct1) + (size_t)fr * ldb + wid * KW + ch1 * (CH * 32) + fq * 8, lda, ldb, an, bn); }
        if (ch == 0) {
#pragma unroll
            for (int i = 0; i < 2; ++i)
#pragma unroll
                for (int j = 0; j < 2; ++j) acc[i][j] = (f32x4){0.f, 0.f, 0.f, 0.f}; }
#pragma unroll
        for (int q = 0; q < CH; ++q) {
            acc[0][0] = __builtin_amdgcn_mfma_f32_16x16x32_bf16(b[0][q], a[0][q], acc[0][0], 0, 0, 0); acc[0][1] = __builtin_amdgcn_mfma_f32_16x16x32_bf16(b[1][q], a[0][q], acc[0][1], 0, 0, 0);
            acc[1][0] = __builtin_amdgcn_mfma_f32_16x16x32_bf16(b[0][q], a[1][q], acc[1][0], 0, 0, 0); acc[1][1] = __builtin_amdgcn_mfma_f32_16x16x32_bf16(b[1][q], a[1][q], acc[1][1], 0, 0, 0); }
        if (ch == NCH - 1) {
#pragma unroll
            for (int i = 0; i < 2; ++i)
#pragma unroll
                for (int j = 0; j < 2; ++j)
#pragma unroll
                    for (int e = 0; e < 4; ++e) RB[(wid * 16 + (i * 2 + j) * 4 + e) * 64 + lane] = acc[i][j][e];
            LDS_BARRIER();
            if (wid < 4) {
                f32x4 v = {0.f, 0.f, 0.f, 0.f};
#pragma unroll
                for (int w = 0; w < 8; ++w)
#pragma unroll
                    for (int e = 0; e < 4; ++e) v[e] += RB[(w * 16 + wid * 4 + e) * 64 + lane];
                const float ss = E(erow, ecol, v, pre, rowpre);
                if (SE::NEED_SS) PSS[((wid >> 1) * 16 + fr) * 8 + (wid & 1) * 4 + fq] = ss;
            }
            LDS_BARRIER();
            if (SE::NEED_SS) { if (tid < 32) { float q = 0.f;
#pragma unroll
                    for (int u = 0; u < 8; ++u) q += PSS[tid * 8 + u];
                    E.store_ss(rt * 32 + tid, ct, q); } }
        }
        if (c + 1 < nchunks) {
#pragma unroll
            for (int i = 0; i < 2; ++i)
#pragma unroll
                for (int q = 0; q < CH; ++q) { a[i][q] = an[i][q]; b[i][q] = bn[i][q]; } }
    }
}
__device__ __forceinline__ float sample_rstd(const float* rsq, int row) {
    const f32x4* q = (const f32x4*)(rsq + row * 32); float s = 0.f;
#pragma unroll
    for (int u = 0; u < 8; ++u) { const f32x4 t = q[u]; s += (t.x + t.y) + (t.z + t.w); }
    return rsqrtf(s * (1.0f / D) + EPS);
}
struct SProbStd { const bf16_t* A; const bf16_t* B; int lda, ldb;
    __device__ __forceinline__ const bf16_t* a_ptr(int) const { return A; }
    __device__ __forceinline__ const bf16_t* b_ptr(int ct) const { return B + (size_t)ct * 32 * ldb; } };
struct SProbPool { const bf16_t* A; const bf16_t* B; int lda, ldb;
    __device__ __forceinline__ const bf16_t* a_ptr(int ct) const { return A + (ct >> 3) * 256; }
    __device__ __forceinline__ const bf16_t* b_ptr(int ct) const { return B + (size_t)ct * 32 * ldb; } };
struct SEpiProj { static constexpr bool NEED_SS = false; typedef int Pre; typedef float RowPre; bf16_t* O; const float* rsq;
    __device__ __forceinline__ RowPre prep_row(int row) const { return sample_rstd(rsq, row); }
    __device__ __forceinline__ Pre prep(int, int) const { return 0; }
    __device__ __forceinline__ float operator()(int row, int col, f32x4 v, Pre, RowPre r) const { v = v * r; col = win_src_col(col);
        u32x2 w; w.x = cvt_pk_bf16(v[0], v[1]); w.y = cvt_pk_bf16(v[2], v[3]); *(u32x2*)(O + ((size_t)MP + row) * NPROJ + col) = w; return 0.f; }
    __device__ __forceinline__ void store_ss(int, int, float) const {} };
struct SEpiFF1 { static constexpr bool NEED_SS = false; typedef int Pre; typedef float RowPre; bf16_t* O; const float* rsq;
    __device__ __forceinline__ RowPre prep_row(int row) const { return sample_rstd(rsq, row); }
    __device__ __forceinline__ Pre prep(int, int) const { return 0; }
    __device__ __forceinline__ float operator()(int row, int col, f32x4 v, Pre, RowPre r) const {
#pragma unroll
        for (int e = 0; e < 4; ++e) { const float a = fmaxf(v[e] * r, 0.f); v[e] = a * a; }
        u32x2 w; w.x = cvt_pk_bf16(v[0], v[1]); w.y = cvt_pk_bf16(v[2], v[3]); *(u32x2*)(O + ((size_t)MP + row) * DFF + col) = w; return 0.f; }
    __device__ __forceinline__ void store_ss(int, int, float) const {} };
struct SEpiRes { static constexpr bool NEED_SS = true; typedef f32x4 Pre; typedef int RowPre; const float* xin_s; bf16_t* XB; float* rsq;
    __device__ __forceinline__ Pre prep(int row, int col) const { if (xin_s) return *(const f32x4*)(xin_s + (size_t)row * D + col);
        const u32x2 q = *(const u32x2*)(XB + ((size_t)MP + row) * D + col); return (f32x4){bf_lo(q.x), bf_hi(q.x), bf_lo(q.y), bf_hi(q.y)}; }
    __device__ __forceinline__ RowPre prep_row(int) const { return 0; }
    __device__ __forceinline__ float operator()(int row, int col, f32x4 v, Pre r, RowPre) const {
        v = v + r;
        u32x2 w; w.x = cvt_pk_bf16(v[0], v[1]); w.y = cvt_pk_bf16(v[2], v[3]); *(u32x2*)(XB + ((size_t)MP + row) * D + col) = w;
        return (v[0] * v[0] + v[1] * v[1]) + (v[2] * v[2] + v[3] * v[3]); }
    __device__ __forceinline__ void store_ss(int row, int ct, float q) const { rsq[row * 32 + ct] = q; } };
struct SEpiMerge { static constexpr bool NEED_SS = false; struct Pre { u32x2 base, g2, g3; f32x4 y; }; typedef int RowPre; const bf16_t* E; bf16_t* MG; const bf16_t* PROJ; const float* gbias; const float* YMS;
    __device__ __forceinline__ Pre prep(int row, int col) const { const size_t gr = (size_t)MP + row; Pre q;
        q.base = *(const u32x2*)(E + gr * D + col); q.g2 = *(const u32x2*)(PROJ + gr * NPROJ + C_GATE + 2 * D + col); q.g3 = *(const u32x2*)(PROJ + gr * NPROJ + C_GATE + 3 * D + col);
        q.y = *(const f32x4*)(YMS + (size_t)row * D + col); return q; }
    __device__ __forceinline__ RowPre prep_row(int) const { return 0; }
    __device__ __forceinline__ float operator()(int row, int col, f32x4 v, const Pre& q, RowPre) const {
        const size_t gr = (size_t)MP + row; const u32x2 base = q.base, g2 = q.g2, g3 = q.g3; const f32x4 y = q.y;
        const f32x4 b2 = *(const f32x4*)(gbias + 2 * D + col), b3 = *(const f32x4*)(gbias + 3 * D + col);
        const float o0 = bf_lo(base.x) + sigm(bf_lo(g2.x) + b2[0]) * v[0] + sigm(bf_lo(g3.x) + b3[0]) * y[0], o1 = bf_hi(base.x) + sigm(bf_hi(g2.x) + b2[1]) * v[1] + sigm(bf_hi(g3.x) + b3[1]) * y[1];
        const float o2 = bf_lo(base.y) + sigm(bf_lo(g2.y) + b2[2]) * v[2] + sigm(bf_lo(g3.y) + b3[2]) * y[2], o3 = bf_hi(base.y) + sigm(bf_hi(g2.y) + b2[3]) * v[3] + sigm(bf_hi(g3.y) + b3[3]) * y[3];
        u32x2 w; w.x = cvt_pk_bf16(o0, o1); w.y = cvt_pk_bf16(o2, o3); *(u32x2*)(MG + gr * D + col) = w; return 0.f; }
    __device__ __forceinline__ void store_ss(int, int, float) const {} };

__device__ __forceinline__ void transpose_item(const float* W, int K, int N, bf16_t* WT, const float* gk, const float* sn, LAS float* scr, int item, int lane, bool remap = false) {
    const int nblk = N / 32, kb = item / nblk, nb = item % nblk, k0 = 64 * kb, n0 = 32 * nb, s0 = remap ? win_src_col(n0) : n0;
    const float snv = sn ? sn[n0 + (lane & 31)] : 1.0f;
    float v[32], g[32];
#pragma unroll
    for (int i = 0; i < 32; ++i) { const int kk = 2 * i + (lane >> 5); v[i] = __builtin_nontemporal_load(W + (size_t)(k0 + kk) * N + s0 + (lane & 31)); g[i] = gk ? gk[k0 + kk] : 1.0f; }
#pragma unroll
    for (int i = 0; i < 32; ++i) { const int kk = 2 * i + (lane >> 5); scr[kk * 33 + (lane & 31)] = v[i] * snv * g[i]; }
    LDS_WAIT(); asm volatile("" ::: "memory");
    const int c = lane & 7;
#pragma unroll
    for (int j = 0; j < 4; ++j) { const int n = (lane >> 3) + 8 * j; const LAS float* s = scr + (8 * c) * 33 + n;
        u32x4 o; o.x = cvt_pk_bf16(s[0 * 33], s[1 * 33]); o.y = cvt_pk_bf16(s[2 * 33], s[3 * 33]); o.z = cvt_pk_bf16(s[4 * 33], s[5 * 33]); o.w = cvt_pk_bf16(s[6 * 33], s[7 * 33]);
        *(u32x4*)(WT + (size_t)(n0 + n) * K + k0 + 8 * c) = o; }
    LDS_WAIT(); asm volatile("" ::: "memory");
}
__device__ __forceinline__ float row_to_bf16(const float* xrow, bf16_t* orow, int lane) {
    f32x4 v[4]; float s = 0.f;
    if (xrow) {
#pragma unroll
        for (int j = 0; j < 4; ++j) { v[j] = *((const f32x4*)xrow + lane + 64 * j); s += (v[j].x * v[j].x + v[j].y * v[j].y) + (v[j].z * v[j].z + v[j].w * v[j].w); }
    } else {
#pragma unroll
        for (int j = 0; j < 4; ++j) v[j] = (f32x4){0.f, 0.f, 0.f, 0.f};
    }
#pragma unroll
    for (int j = 0; j < 4; ++j) { u32x2 w; w.x = cvt_pk_bf16(v[j].x, v[j].y); w.y = cvt_pk_bf16(v[j].z, v[j].w); *((u32x2*)orow + lane + 64 * j) = w; }
    return wave_sum(s);
}

__device__ __forceinline__ void prepass_prompt(const Params& p, int l, int T, const int cont, const int wid, LAS unsigned char* lds, const bf16_t* PROJ, bf16_t* Eb, bf16_t* PL) {
    const int lane = fresh_lane(), tid = wid * 64 + lane;
    const int b = T >> 6, tt = T & 63, t0 = tt * 32, c0 = 2 * tid;
    const bf16_t* PRb = PROJ + (size_t)b * SEQ * NPROJ;
    LAS unsigned* GL = (LAS unsigned*)lds;
    LAS float* RED = (LAS float*)(lds + LDS_X + 8192);
    LAS float* FIN = RED + 128;
    {   const int c8 = (tid & 127) * 8, rsub = tid >> 7;
        const int rbase = cont ? 30 : 0;
        u32x4 av[16];
#pragma unroll
        for (int ps = 0; ps < 16; ++ps) { const int rr = rbase + ps * 4 + rsub, t = t0 - 30 + rr; av[ps] = (u32x4){0u, 0u, 0u, 0u};
            if (rr < 62 && t >= 0) { const bf16_t* rp = PRb + (size_t)t * NPROJ; av[ps] = *(const u32x4*)(rp + C_G1 + c8); } }
        if (cont) { u32x4 mv[8];
#pragma unroll
            for (int it = 0; it < 8; ++it) { const int q = it * 512 + tid; if (q < 30 * 128) mv[it] = *(const LAS u32x4*)(GL + (32 + (q >> 7)) * 512 + (q & 127) * 4); }
            LDS_BARRIER();
#pragma unroll
            for (int it = 0; it < 8; ++it) { const int q = it * 512 + tid; if (q < 30 * 128) *(LAS u32x4*)(GL + (q >> 7) * 512 + (q & 127) * 4) = mv[it]; } }
#pragma unroll
        for (int ps = 0; ps < 16; ++ps) { const int rr = rbase + ps * 4 + rsub; if (rr < 62) *(LAS u32x4*)(GL + rr * 512 + (c8 >> 1)) = av[ps]; } }
    f32x2 wb[31];
#pragma unroll
    for (int k = 0; k < 31; ++k) wb[k] = *(const f32x2*)(p.conv_b_w + ((size_t)l * 31 + k) * D + c0);
    const f32x2 cbias = *(const f32x2*)(p.conv_b_bias + l * D + c0), lng = *(const f32x2*)(p.ln_g + l * D + c0), lnb = *(const f32x2*)(p.ln_b + l * D + c0);
    const f32x2 wa0 = *(const f32x2*)(p.conv_a_w + (l * 3 + 0) * D + c0), wa1 = *(const f32x2*)(p.conv_a_w + (l * 3 + 1) * D + c0), wa2 = *(const f32x2*)(p.conv_a_w + (l * 3 + 2) * D + c0);
    const f32x2 gb0 = *(const f32x2*)(p.gate_bias + l * 4 * D + c0), gb1 = *(const f32x2*)(p.gate_bias + l * 4 * D + D + c0);
    f32x2 u1 = {0.f, 0.f}, u2 = {0.f, 0.f}; unsigned pw[23];
#pragma unroll
    for (int i = 0; i < 15; ++i) pw[i] = 0u;
    if (t0 > 0) {
        const bf16_t* r2 = PRb + (size_t)(t0 - 2) * NPROJ + c0; const bf16_t* r1 = r2 + NPROJ;
        const unsigned q2 = *(const unsigned*)(r2 + C_HA), q1 = *(const unsigned*)(r1 + C_HA);
        u2 = (f32x2){bf_lo(q2), bf_hi(q2)}; u1 = (f32x2){bf_lo(q1), bf_hi(q1)};
#pragma unroll
        for (int i = 0; i < 15; ++i) pw[i] = *(const unsigned*)(PRb + (size_t)(t0 - 15 + i) * NPROJ + C_PIN + c0);
    }
    LDS_BARRIER();
    const int gsel = wid >> 1;
    float* outp = p.out;
    unsigned pcarry = 0u;
    if (t0 > 0) pcarry = *(const unsigned*)(PRb + (size_t)(t0 - 16) * NPROJ + C_PIN + c0);
    f32x2 psum = {0.f, 0.f};
    { const int wnd = 2 << gsel;
#pragma unroll
      for (int i = 1; i <= 16; ++i) { const unsigned q = (i <= 15) ? pw[15 - i] : pcarry; if (i <= wnd) { psum.x += bf_lo(q); psum.y += bf_hi(q); } } }
#pragma unroll 1
    for (int g = 0; g < 4; ++g) {
        const int tg = t0 + 8 * g;
        unsigned ha[8], ba[8], g0[8], g1[8];
#pragma unroll
        for (int j = 0; j < 8; ++j) { const bf16_t* rp = PRb + (size_t)(tg + j) * NPROJ + c0;
            ha[j] = *(const unsigned*)(rp + C_HA); pw[15 + j] = *(const unsigned*)(rp + C_PIN); }
        f32x2 z[8];
#pragma unroll
        for (int j = 0; j < 8; ++j) z[j] = cbias;
#pragma unroll
        for (int i = 0; i < 38; ++i) { const unsigned wv = GL[(8 * g + i) * 512 + tid]; const f32x2 x = {bf_lo(wv), bf_hi(wv)};
#pragma unroll
            for (int j = 0; j < 8; ++j) { const int k = i - j; if (k >= 0 && k < 31) z[j] += wb[k] * x; } }
        asm volatile("" ::: "memory");
#pragma unroll
        for (int j = 0; j < 8; ++j) { const bf16_t* rp = PRb + (size_t)(tg + j) * NPROJ + c0;
            ba[j] = *(const unsigned*)(rp + C_BA); g0[j] = *(const unsigned*)(rp + C_GATE); g1[j] = *(const unsigned*)(rp + C_GATE + D); }
#pragma unroll
        for (int j = 0; j < 8; ++j) { const float s1 = wave_sum_dpp(z[j].x + z[j].y), s2 = wave_sum_dpp(z[j].x * z[j].x + z[j].y * z[j].y);
            if (lane == 0) { RED[wid * 16 + j] = s1; RED[wid * 16 + 8 + j] = s2; } }
        LDS_BARRIER();
        if (tid < 16) { float s = 0.f;
#pragma unroll
            for (int w = 0; w < 8; ++w) s += RED[w * 16 + tid];
            FIN[tid] = s; }
        LDS_BARRIER();
#pragma unroll
        for (int j = 0; j < 8; ++j) {
            const int t = tg + j; const size_t row = (size_t)b * SEQ + t;
            const float mean = FIN[j] * (1.0f / D), var = FIN[8 + j] * (1.0f / D) - mean * mean, rstd = rsqrtf(var + EPS);
            f32x2 yb = (z[j] - mean) * rstd * lng + lnb; yb.x *= sigm(yb.x); yb.y *= sigm(yb.y);
            const f32x2 u0 = {bf_lo(ha[j]), bf_hi(ha[j])};
            f32x2 ya = wa0 * u2 + wa1 * u1 + wa2 * u0; ya.x *= bf_lo(ba[j]); ya.y *= bf_hi(ba[j]);
            u2 = u1; u1 = u0;
            const float e0 = sigm(bf_lo(g0[j]) + gb0.x) * ya.x + sigm(bf_lo(g1[j]) + gb1.x) * yb.x, e1 = sigm(bf_hi(g0[j]) + gb0.y) * ya.y + sigm(bf_hi(g1[j]) + gb1.y) * yb.y;
            *(unsigned*)(Eb + row * D + c0) = cvt_pk_bf16(e0, e1);
            { const unsigned pnw = pw[15 + j]; unsigned pold;
              { const unsigned p16 = (j >= 1) ? pw[j >= 1 ? j - 1 : 0] : pcarry; pold = gsel == 0 ? pw[13 + j] : (gsel == 1 ? pw[11 + j] : (gsel == 2 ? pw[7 + j] : p16)); }
              const f32x2 pn = {bf_lo(pnw), bf_hi(pnw)}, po = {bf_lo(pold), bf_hi(pold)};
              psum += pn - po;
              const int wnd = 2 << gsel; const float icnt = 1.0f / (float)(t + 1 < wnd ? t + 1 : wnd);
              *(unsigned*)(PL + row * D + c0) = cvt_pk_bf16(psum.x * icnt - pn.x, psum.y * icnt - pn.y); }
        }
        pcarry = pw[7];
#pragma unroll
        for (int i = 0; i < 15; ++i) pw[i] = pw[i + 8];
    }
    if (tt == 63) {
#pragma unroll
        for (int i = 0; i < 2; ++i) { const unsigned uu = *(const unsigned*)(PRb + (size_t)(SEQ - 2 + i) * NPROJ + c0 + C_HA);
            *(f32x2*)(outp + OUT_CAP + ((size_t)(l * NBATCH + b) * 2 + i) * D + c0) = (f32x2){bf_lo(uu), bf_hi(uu)}; }
#pragma unroll 5
        for (int i = 0; i < 15; ++i) { const unsigned pv = *(const unsigned*)(PRb + (size_t)(SEQ - 15 + i) * NPROJ + C_PIN + c0);
            *(f32x2*)(outp + OUT_PPP + ((size_t)(l * NBATCH + b) * 15 + i) * D + c0) = (f32x2){bf_lo(pv), bf_hi(pv)}; }
#pragma unroll 6
        for (int i = 0; i < 30; ++i) { const unsigned wv = GL[(32 + i) * 512 + tid];
            *(f32x2*)(outp + OUT_CBP + ((size_t)(l * NBATCH + b) * 30 + i) * D + c0) = (f32x2){bf_lo(wv), bf_hi(wv)}; }
    }
    LDS_BARRIER();
}
__device__ __forceinline__ void prepass_sample(const Params& p, int l, int sb, const int wid, LAS unsigned char* lds, const bf16_t* PROJ, bf16_t* Eb, bf16_t* PL) {
    const int lane = fresh_lane(), tid = wid * 64 + lane, c0 = 2 * tid;
    LAS float* RED = (LAS float*)(lds + LDS_X + 8192);
    const size_t row = (size_t)MP + sb; const bf16_t* rp = PROJ + row * NPROJ + c0; float* outp = p.out;
    const unsigned ha = *(const unsigned*)(rp + C_HA), ba = *(const unsigned*)(rp + C_BA), ca = *(const unsigned*)(rp + C_CA), q1 = *(const unsigned*)(rp + C_G1), q2 = *(const unsigned*)(rp + C_G2),
        pin = *(const unsigned*)(rp + C_PIN), g0 = *(const unsigned*)(rp + C_GATE), g1 = *(const unsigned*)(rp + C_GATE + D);
    const size_t ls = (size_t)l * NS + sb;
    const f32x2 sa0 = *(const f32x2*)(p.st_a + (ls * 2 + 0) * D + c0), sa1 = *(const f32x2*)(p.st_a + (ls * 2 + 1) * D + c0);
    const f32x2 wa0 = *(const f32x2*)(p.conv_a_w + (l * 3 + 0) * D + c0), wa1 = *(const f32x2*)(p.conv_a_w + (l * 3 + 1) * D + c0), wa2 = *(const f32x2*)(p.conv_a_w + (l * 3 + 2) * D + c0);
    const f32x2 u0 = {bf_lo(ca) * bf_lo(ha), bf_hi(ca) * bf_hi(ha)};
    f32x2 ya = wa0 * sa0 + wa1 * sa1 + wa2 * u0; ya.x *= bf_lo(ba); ya.y *= bf_hi(ba);
    *(f32x2*)(outp + OUT_CAS + (ls * 2 + 0) * D + c0) = sa1; *(f32x2*)(outp + OUT_CAS + (ls * 2 + 1) * D + c0) = u0;
    const f32x2 glu = {bf_lo(q1) * sigm(bf_lo(q2)), bf_hi(q1) * sigm(bf_hi(q2))};
    f32x2 z = *(const f32x2*)(p.conv_b_bias + l * D + c0) + *(const f32x2*)(p.conv_b_w + ((size_t)l * 31 + 30) * D + c0) * glu;
#pragma unroll 10
    for (int k = 0; k < 30; ++k) { const f32x2 s = *(const f32x2*)(p.st_b + (ls * 30 + k) * D + c0); z += *(const f32x2*)(p.conv_b_w + ((size_t)l * 31 + k) * D + c0) * s;
        if (k >= 1) *(f32x2*)(outp + OUT_CBS + (ls * 30 + k - 1) * D + c0) = s; }
    *(f32x2*)(outp + OUT_CBS + (ls * 30 + 29) * D + c0) = glu;
    const float s1 = wave_sum_dpp(z.x + z.y), s2 = wave_sum_dpp(z.x * z.x + z.y * z.y);
    if (lane == 0) { RED[wid * 2] = s1; RED[wid * 2 + 1] = s2; }
    LDS_BARRIER();
    float S1 = 0.f, S2 = 0.f;
#pragma unroll
    for (int w = 0; w < 8; ++w) { S1 += RED[w * 2]; S2 += RED[w * 2 + 1]; }
    const float mean = S1 * (1.0f / D), var = S2 * (1.0f / D) - mean * mean, rstd = rsqrtf(var + EPS);
    f32x2 yb = (z - mean) * rstd * *(const f32x2*)(p.ln_g + l * D + c0) + *(const f32x2*)(p.ln_b + l * D + c0); yb.x *= sigm(yb.x); yb.y *= sigm(yb.y);
    const f32x2 gb0 = *(const f32x2*)(p.gate_bias + l * 4 * D + c0), gb1 = *(const f32x2*)(p.gate_bias + l * 4 * D + D + c0);
    const float e0 = sigm(bf_lo(g0) + gb0.x) * ya.x + sigm(bf_lo(g1) + gb1.x) * yb.x, e1 = sigm(bf_hi(g0) + gb0.y) * ya.y + sigm(bf_hi(g1) + gb1.y) * yb.y;
    *(unsigned*)(Eb + row * D + c0) = cvt_pk_bf16(e0, e1);
    const int gsel = wid >> 1, wnd = 2 << gsel; const f32x2 pn = {bf_lo(pin), bf_hi(pin)}; f32x2 s = pn;
#pragma unroll
    for (int i = 0; i < 15; ++i) { const f32x2 sp = *(const f32x2*)(p.st_p + (ls * 15 + i) * D + c0); if (i >= 16 - wnd) s += sp;
        if (i >= 1) *(f32x2*)(outp + OUT_PPS + (ls * 15 + i - 1) * D + c0) = sp; }
    *(f32x2*)(outp + OUT_PPS + (ls * 15 + 14) * D + c0) = pn;
    const float iw = 1.0f / (float)wnd;
    *(unsigned*)(PL + row * D + c0) = cvt_pk_bf16(s.x * iw - pn.x, s.y * iw - pn.y);
    LDS_BARRIER();
}
__device__ __forceinline__ void sample_attn(const Params& p, int l, int item, const int wid, LAS unsigned char* lds, const bf16_t* PROJ, float* YMS) {
    const int lane = fresh_lane(), tid = wid * 64 + lane, sb = item >> 2, h = item & 3;
    LAS float* OB = (LAS float*)lds;
    LAS float* MS = OB + 2048;
    const u32x2 qw = *(const u32x2*)(PROJ + ((size_t)MP + sb) * NPROJ + C_Q + h * 256 + 4 * lane);
    const float sc = 0.0625f * 1.44269504f;
    const f32x4 q = {bf_lo(qw.x) * sc, bf_hi(qw.x) * sc, bf_lo(qw.y) * sc, bf_hi(qw.y) * sc};
    const size_t base = ((((size_t)l * NS + sb) * NMEM + wid * 32) * 4 + h) * 256 + 4 * lane;
    const float* Kp = p.cache_k + base; const float* Vp = p.cache_v + base;
    f32x4 kv[32]; float s[32];
#pragma unroll
    for (int i = 0; i < 32; ++i) kv[i] = __builtin_nontemporal_load((const f32x4*)(Kp + (size_t)i * 1024));
#pragma unroll
    for (int i = 0; i < 32; ++i) s[i] = wave_sum((kv[i].x * q.x + kv[i].y * q.y) + (kv[i].z * q.z + kv[i].w * q.w));
#pragma unroll
    for (int i = 0; i < 32; ++i) kv[i] = __builtin_nontemporal_load((const f32x4*)(Vp + (size_t)i * 1024));
    float mx = s[0];
#pragma unroll
    for (int i = 1; i < 32; ++i) mx = fmaxf(mx, s[i]);
    float sum = 0.f; f32x4 o = {0.f, 0.f, 0.f, 0.f};
#pragma unroll
    for (int i = 0; i < 32; ++i) { const float pr = __builtin_amdgcn_exp2f(s[i] - mx); sum += pr; o += kv[i] * pr; }
    *(LAS f32x4*)(OB + wid * 256 + 4 * lane) = o;
    if (lane == 0) { MS[wid] = mx; MS[8 + wid] = sum; }
    LDS_BARRIER();
    if (tid < 256) { float gm = MS[0];
#pragma unroll
        for (int w = 1; w < 8; ++w) gm = fmaxf(gm, MS[w]);
        float tot = 0.f, acc = 0.f;
#pragma unroll
        for (int w = 0; w < 8; ++w) { const float f = __builtin_amdgcn_exp2f(MS[w] - gm); tot += MS[8 + w] * f; acc += OB[w * 256 + tid] * f; }
        YMS[(size_t)sb * D + h * 256 + tid] = acc / tot; }
    LDS_BARRIER();
}

__global__ void __launch_bounds__(512, 2) mega_fwd(Params p) {
    extern __shared__ __attribute__((aligned(16))) unsigned char lds_raw[];
    LAS unsigned char* lds = (LAS unsigned char*)lds_raw;
    const int wave = __builtin_amdgcn_readfirstlane(threadIdx.x >> 6);
    const int G = gridDim.x, bx = blockIdx.x;
    unsigned char* ws = p.ws;
#define PHASE_BEGIN() size_t wsz = 0; int bxo = bx, Go = G, lo = l, wvo = wave; unsigned ldsv = 0u; asm volatile("" : "+s"(wsz), "+s"(bxo), "+s"(Go), "+s"(lo), "+s"(ldsv), "+s"(wvo)); \
    unsigned char* wso = ws + wsz;     \
    LAS unsigned char* ldso = lds + ldsv; \
    bf16_t* WIN = (bf16_t*)(wso + WS_WIN); bf16_t* WKV = (bf16_t*)(wso + WS_WKV); bf16_t* WO = (bf16_t*)(wso + WS_WO); bf16_t* W1 = (bf16_t*)(wso + WS_W1); bf16_t* W2 = (bf16_t*)(wso + WS_W2); \
    bf16_t* WP = (bf16_t*)(wso + WS_WP); bf16_t* XB = (bf16_t*)(wso + WS_XB); bf16_t* MEMB = (bf16_t*)(wso + WS_MEMB); bf16_t* KB = (bf16_t*)(wso + WS_KB); bf16_t* VT = (bf16_t*)(wso + WS_VT); \
    bf16_t* Eb = (bf16_t*)(wso + WS_E); bf16_t* PL = (bf16_t*)(wso + WS_PL); bf16_t* PP = (bf16_t*)(wso + WS_PP); bf16_t* MG = (bf16_t*)(wso + WS_MG); float* X = (float*)(wso + WS_X); \
    float* YMS = (float*)(wso + WS_YMS); float* RSS = (float*)(wso + WS_RSS); float* RSM = (float*)(wso + WS_RSM); float* RSQ = (float*)(wso + WS_RSQ); \
    float* rsqA = RSQ + (2 * lo) * 4096; float* rsqB = RSQ + (2 * lo + 1) * 4096; float* rsqN = RSQ + ((2 * lo + 2) & 3) * 4096; (void)rsqA; (void)rsqB; (void)rsqN; bf16_t* PROJ = (bf16_t*)(wso + WS_PROJ); bf16_t* HB = PROJ; \
    float* rssA = RSS + (size_t)(2 * lo) * MPAD * 16; float* rssB = RSS + (size_t)(2 * lo + 1) * MPAD * 16; float* rssN = RSS + (size_t)((2 * lo + 2) & 3) * MPAD * 16; \
    (void)WIN; (void)WKV; (void)WO; (void)W1; (void)W2; (void)WP; (void)XB; (void)MEMB; (void)KB; (void)VT; (void)Eb; (void)PL; (void)PP; (void)MG; (void)X; (void)YMS; (void)RSS; (void)RSM; (void)PROJ; (void)HB; (void)rssA; (void)rssB; (void)rssN;
    cg::grid_group grid = cg::this_grid();
#if USE_CG_SYNC
#define GRID_BAR() grid.sync()
#else
    volatile LAS unsigned* bst = (volatile LAS unsigned*)(lds + LDS_X + 12288);
    if (threadIdx.x < 2) bst[threadIdx.x] = 0u;
    if (bx == 0) for (int i = threadIdx.x; i < XCD_BAR_WORDS; i += 512) __hip_atomic_store((unsigned*)(ws + WS_CTL) + i, 0u, __ATOMIC_RELAXED, __HIP_MEMORY_SCOPE_AGENT);
    __syncthreads();
    XcdBarrier bar; bar.bar = (unsigned*)(ws + WS_CTL); bar.x = 0; bar.st = bst;
#define GRID_BAR() xcd_barrier(bar)
#endif

    {
        const int l = 0; PHASE_BEGIN();
        const int lane = fresh_lane();
        LAS float* scr = (LAS float*)(ldso + wvo * 8448);
        const int gw = bxo * 8 + wvo, NGW = Go * 8;
        constexpr int I_IN = 16 * (NPROJ / 32), I_KV = 16 * 64, I_O = 16 * 32, I_1 = 16 * 128, I_2 = 64 * 32, I_P = 4 * 8, PER_L = I_IN + I_KV + I_O + I_1 + I_2 + 4 * I_P;
        for (int rep = 0; rep < REP_P0; ++rep)
        for (int it = gw; it < DEPTH * PER_L; it += NGW) {
            const int l = it / PER_L; int r = it % PER_L;
            if (r < I_IN) { transpose_item(p.w_in + (size_t)l * D * NPROJ, D, NPROJ, WIN + (size_t)l * NPROJ * D, p.norm_mix + l * D, nullptr, scr, r, lane, true); continue; } r -= I_IN;
            if (r < I_KV) { transpose_item(p.w_kv + (size_t)l * D * 2048, D, 2048, WKV + (size_t)l * 2048 * D, p.norm_mem + l * D, nullptr, scr, r, lane); continue; } r -= I_KV;
            if (r < I_O) { transpose_item(p.w_o + (size_t)l * D * D, D, D, WO + (size_t)l * D * D, nullptr, nullptr, scr, r, lane); continue; } r -= I_O;
            if (r < I_1) { transpose_item(p.w_ff1 + (size_t)l * D * DFF, D, DFF, W1 + (size_t)l * DFF * D, p.norm_ffn + l * D, nullptr, scr, r, lane); continue; } r -= I_1;
            if (r < I_2) { transpose_item(p.w_ff2 + (size_t)l * DFF * D, DFF, D, W2 + (size_t)l * D * DFF, nullptr, nullptr, scr, r, lane); continue; } r -= I_2;
            { const int g = r / I_P; transpose_item(p.pool_w + ((size_t)l * 4 + g) * 65536, 256, 256, WP + ((size_t)l * 4 + g) * 65536, nullptr, p.pool_scale + l * D + g * 256, scr, r % I_P, lane); }
        }
        for (int rep = 0; rep < REP_P0; ++rep)
        for (int m = gw; m < MPAD; m += NGW) {
            const float* src = m < MP ? p.x_prompt + (size_t)m * D : (m < MROWS ? p.x_sample + (size_t)(m - MP) * D : nullptr);
            const float ss = row_to_bf16(src, XB + (size_t)m * D, lane);
            if (lane < 16) RSS[(size_t)m * 16 + lane] = lane == 0 ? ss : 0.f;
            if (m >= MP && m < MROWS && lane < 32) RSQ[(m - MP) * 32 + lane] = lane == 0 ? ss : 0.f;
        }
        for (int m = gw; m < 2048; m += NGW) { const float ss = row_to_bf16(p.mem_prompt + (size_t)m * D, MEMB + (size_t)m * D, lane); if (lane == 0) RSM[m] = ss; }
    }
    grid.sync();
#if !USE_CG_SYNC
    bar = xcd_barrier_post((unsigned*)(ws + WS_CTL), bst);
#endif

    {
        const int l = 0; PHASE_BEGIN();
        ProbStd P{(const char*)MEMB, (const char*)WKV, D, D, D}; pg8::StaticOrder S; S.init(8, 16, Go, bxo);
        EpiKV E{p.out, KB, VT, RSM};
        pg8::gemm_phase(ldso, P, S, E, wvo);
        SProbStd SP{XB + (size_t)MP * D, WIN, D, D}; SEpiProj SE{PROJ, RSQ};
        constexpr int NT = 4 * (NPROJ / 32), NT_HI = 1024;
        if (Go == 256) { if (bxo >= 128) skinny_gemm<4>(ldso, SP, SE, NT_HI, bxo - 128, 128, wvo, 0); else skinny_gemm<4>(ldso, SP, SE, NT - NT_HI, bxo, 128, wvo, NT_HI); }
        else skinny_gemm<4>(ldso, SP, SE, NT, bxo, Go, wvo);
    }
    GRID_BAR();
#pragma unroll 1
    for (int l = 0; l < DEPTH; ++l) {
        {
            PHASE_BEGIN();
            const int flip = (bxo >> 3) & 1;
            ProbStd P{(const char*)XB, (const char*)(WIN + (size_t)lo * NPROJ * D), D, D, D}; pg8::StaticOrder S; S.init(MP / 256, NPROJ / 256, Go, bxo);
            EpiProj E{PROJ, NPROJ, rssA};
#pragma unroll 1
            for (int step = 0; step < 3; ++step) {
                if (step == 1) pg8::gemm_phase(ldso, P, S, E, wvo);
                else if ((step == 0) == (flip != 0)) {
                    for (int sb = bxo; sb < NS; sb += Go) prepass_sample(p, lo, sb, wvo, ldso, PROJ, Eb, PL);
                    for (int it = bxo; it < NS * 4; it += Go) sample_attn(p, lo, it, wvo, ldso, PROJ, YMS);
                }
            }
        }
        GRID_BAR();
        {
            PHASE_BEGIN();
            for (int T2 = bxo; T2 < 256; T2 += Go)
#pragma unroll 1
                for (int h = 0; h < 2; ++h) prepass_prompt(p, lo, 2 * T2 + h, h, wvo, ldso, PROJ, Eb, PL);
            ProbS P{(const char*)PROJ, (const char*)(KB + (size_t)lo * 2048 * D), NPROJ, D, 256}; OrderS S{Go, bxo};
            EpiS E{PP};
            pg8::gemm_phase(ldso, P, S, E, wvo);
            SProbPool SP{PL + (size_t)MP * D, WP + (size_t)lo * 4 * 65536, D, 256}; SEpiMerge SE{Eb, MG, PROJ, p.gate_bias + lo * 4 * D, YMS};
            skinny_gemm<1>(ldso, SP, SE, 4 * (D / 32), bxo, Go, wvo);
        }
        GRID_BAR();
        {
            PHASE_BEGIN();
            ProbMerge P{(const char*)PL, (const char*)(WP + (size_t)lo * 4 * 65536), (long)((const char*)PP - (const char*)PL), (long)((const char*)(VT + (size_t)lo * 32 * 65536) - (const char*)(WP + (size_t)lo * 4 * 65536)), D, 256, 256}; OrderMerge S{Go, bxo};
            EpiMerge E{Eb, MG, PROJ, p.gate_bias + lo * 4 * D};
            pg8::gemm_phase(ldso, P, S, E, wvo);
            SProbStd SP{MG + (size_t)MP * D, WO + (size_t)lo * D * D, D, D}; SEpiRes SE{lo == 0 ? p.x_sample : nullptr, XB, rsqB};
            skinny_gemm<4>(ldso, SP, SE, 4 * (D / 32), bxo, Go, wvo);
        }
        GRID_BAR();
        {
            PHASE_BEGIN();
            ProbStd P{(const char*)MG, (const char*)(WO + (size_t)lo * D * D), D, D, D}; pg8::StaticOrder S; S.init(MP / 256, 4, Go, bxo);
            EpiRes E{lo == 0 ? p.x_prompt : nullptr, XB, rssB};
            pg8::gemm_phase(ldso, P, S, E, wvo);
            SProbStd SP{XB + (size_t)MP * D, W1 + (size_t)lo * DFF * D, D, D}; SEpiFF1 SE{HB, rsqB};
            skinny_gemm<4>(ldso, SP, SE, 4 * (DFF / 32), bxo, Go, wvo);
        }
        GRID_BAR();
        {
            PHASE_BEGIN();
            ProbStd P{(const char*)XB, (const char*)(W1 + (size_t)lo * DFF * D), D, D, D}; pg8::StaticOrder S; S.init(MP / 256, DFF / 256, Go, bxo);
            EpiFF1 E{HB, rssB};
            pg8::gemm_phase(ldso, P, S, E, wvo);
            SProbStd SP{HB + (size_t)MP * DFF, W2 + (size_t)lo * D * DFF, DFF, DFF}; SEpiRes SE{nullptr, XB, rsqN};
            skinny_gemm<16>(ldso, SP, SE, 4 * (D / 32), bxo, Go, wvo);
        }
        GRID_BAR();
        {
            PHASE_BEGIN();
            ProbStd P{(const char*)HB, (const char*)(W2 + (size_t)lo * D * DFF), DFF, DFF, DFF}; pg8::StaticOrder S; S.init(MP / 256, 4, Go, bxo);
            EpiRes E{nullptr, XB, rssN};
            pg8::gemm_phase(ldso, P, S, E, wvo);
            if (lo + 1 < DEPTH) { SProbStd SP{XB + (size_t)MP * D, WIN + (size_t)(lo + 1) * NPROJ * D, D, D}; SEpiProj SE{PROJ, rsqN};
                skinny_gemm<4>(ldso, SP, SE, 4 * (NPROJ / 32), bxo, Go, wvo); }
        }
        GRID_BAR();
    }
    {
        const int l = 0; PHASE_BEGIN();
        const int lane = fresh_lane();
        const int gw = bxo * 8 + wvo, NGW = Go * 8;
        for (int m = gw; m < MROWS; m += NGW) {
            const u32x2* xr = (const u32x2*)(XB + (size_t)m * D) + lane; f32x4 v[4]; float s = 0.f;
#pragma unroll
            for (int j = 0; j < 4; ++j) { const u32x2 q = xr[64 * j]; v[j] = (f32x4){bf_lo(q.x), bf_hi(q.x), bf_lo(q.y), bf_hi(q.y)}; s += (v[j].x * v[j].x + v[j].y * v[j].y) + (v[j].z * v[j].z + v[j].w * v[j].w); }
            const float rstd = rsqrtf(wave_sum(s) * (1.0f / D) + EPS);
            f32x4* o = (f32x4*)(p.out + (size_t)m * D) + lane;
#pragma unroll
            for (int j = 0; j < 4; ++j) o[64 * j] = v[j] * rstd * *((const f32x4*)p.norm_final + lane + 64 * j);
        }
    }
}

extern "C" void kernel_launch(void* const* d_in, const int* in_sizes, int n_in, void* d_out, int out_size, void* d_ws, size_t ws_size, hipStream_t stream) {
    static int grid = 0;
    if (grid == 0) {
        if (n_in != 25 || (size_t)out_size != OUT_END || ws_size < WS_END) { fprintf(stderr, "kernel_launch: unexpected shapes (n_in %d out %d ws %zu need %zu)\n", n_in, out_size, ws_size, (size_t)WS_END); grid = -1; return; }
        int dev = 0, cus = 0, per_cu = 0;
        hipGetDevice(&dev); hipDeviceGetAttribute(&cus, hipDeviceAttributeMultiprocessorCount, dev);
        if (hipFuncSetAttribute((const void*)mega_fwd, hipFuncAttributeMaxDynamicSharedMemorySize, LDS_BYTES) != hipSuccess) { fprintf(stderr, "kernel_launch: hipFuncSetAttribute failed\n"); grid = -1; return; }
        if (hipOccupancyMaxActiveBlocksPerMultiprocessor(&per_cu, (const void*)mega_fwd, 512, LDS_BYTES) != hipSuccess || per_cu < 1) { fprintf(stderr, "kernel_launch: occupancy query gave %d\n", per_cu); per_cu = 1; }
        (void)hipGetLastError();
        grid = cus * per_cu;
    }
    if (grid < 0) return;
    Params p{};
    const float** pf = (const float**)&p;
    for (int i = 0; i < 25; ++i) pf[i] = (const float*)d_in[i];
    p.out = (float*)d_out; p.ws = (unsigned char*)d_ws;
    void* args[] = {&p};
    hipError_t e = hipLaunchCooperativeKernel((const void*)mega_fwd, dim3(grid), dim3(512), args, LDS_BYTES, stream);
    if (e != hipSuccess) fprintf(stderr, "kernel_launch: cooperative launch failed: %s (grid %d)\n", hipGetErrorString(e), grid);
}
```

```cpp
#include <hip/hip_runtime.h>
#include <hip/hip_cooperative_groups.h>
#include <cstdio>
#include <cstdint>
namespace cg = cooperative_groups;

#define LAS __attribute__((address_space(3)))
typedef unsigned short bf16_t;
typedef short bf16x8 __attribute__((ext_vector_type(8)));
typedef float f32x4 __attribute__((ext_vector_type(4)));
typedef float f32x2 __attribute__((ext_vector_type(2)));
typedef unsigned u32x4 __attribute__((ext_vector_type(4)));
typedef unsigned u32x2 __attribute__((ext_vector_type(2)));

#define REP_P0 1
#define REP_P2 1
#define REP_P3 1
#define REP_SATT 1
#define REP_P4 1
#define REP_P5 1
#define REP_P7 1
#define REP_SK 1
#define REP_P1 1
#define REP_P6 1
#define REP_P8 1
#define REP_FIN 1
#ifndef USE_CG_SYNC
#define USE_CG_SYNC 0
#endif

constexpr int D = 1024, NBATCH = 8, SEQ = 2048, MP = NBATCH * SEQ, NS = 128, MROWS = MP + NS, MPAD = 16640;
constexpr int NPROJ = 11264, NMEM = 256, DFF = 4096, DEPTH = 2;
constexpr int C_HA = 0, C_BA = 1024, C_CA = 2048, C_G1 = 3072, C_G2 = 4096, C_PIN = 5120, C_Q = 6144, C_GATE = 7168;
constexpr float EPS = 1e-6f;
constexpr size_t OUT_YP = 0, OUT_YS = (size_t)MP * D, OUT_MK = OUT_YS + (size_t)NS * D, OUT_MV = OUT_MK + (size_t)DEPTH * NBATCH * NMEM * D;
constexpr size_t OUT_CAP = OUT_MV + (size_t)DEPTH * NBATCH * NMEM * D, OUT_CBP = OUT_CAP + (size_t)DEPTH * NBATCH * 2 * D, OUT_PPP = OUT_CBP + (size_t)DEPTH * NBATCH * 30 * D;
constexpr size_t OUT_CAS = OUT_PPP + (size_t)DEPTH * NBATCH * 15 * D, OUT_CBS = OUT_CAS + (size_t)DEPTH * NS * 2 * D, OUT_PPS = OUT_CBS + (size_t)DEPTH * NS * 30 * D;
constexpr size_t OUT_END = OUT_PPS + (size_t)DEPTH * NS * 15 * D;
static_assert(OUT_END == 38387712, "output size");
constexpr size_t WS_CTL = 0, CTL_BYTES = 65536;
constexpr size_t WS_WIN = CTL_BYTES;
constexpr size_t WS_WKV = WS_WIN + (size_t)DEPTH * NPROJ * D * 2;
constexpr size_t WS_WO = WS_WKV + (size_t)DEPTH * 2048 * D * 2;
constexpr size_t WS_W1 = WS_WO + (size_t)DEPTH * D * D * 2;
constexpr size_t WS_W2 = WS_W1 + (size_t)DEPTH * DFF * D * 2;
constexpr size_t WS_WP = WS_W2 + (size_t)DEPTH * DFF * D * 2;
constexpr size_t WS_XB = WS_WP + (size_t)DEPTH * 4 * 256 * 256 * 2;
constexpr size_t WS_MEMB = WS_XB + (size_t)MPAD * D * 2;
constexpr size_t WS_KB = WS_MEMB + (size_t)2048 * D * 2;
constexpr size_t WS_VT = WS_KB + (size_t)DEPTH * 2048 * D * 2;
constexpr size_t WS_E = WS_VT + (size_t)DEPTH * 2048 * D * 2;
constexpr size_t WS_PL = WS_E + (size_t)MPAD * D * 2;
constexpr size_t WS_PP = WS_PL + (size_t)MPAD * D * 2;
constexpr size_t WS_MG = WS_PP + (size_t)MP * D * 2;
constexpr size_t WS_X = WS_MG + (size_t)MPAD * D * 2;
constexpr size_t WS_YMS = WS_X + (size_t)MPAD * D * 4;
constexpr size_t WS_RSS = WS_YMS + (size_t)NS * D * 4;
constexpr size_t RSS_BUF = (size_t)MPAD * 16 * 4;
constexpr size_t WS_RSM = WS_RSS + 4 * RSS_BUF;
constexpr size_t WS_RSQ = WS_RSM + 2048 * 4 + 256 * 31;
constexpr size_t WS_PROJ = WS_RSQ + 4 * 128 * 32 * 4;
constexpr size_t WS_END = WS_PROJ + (size_t)MPAD * NPROJ * 2;
static_assert(WS_PROJ % 256 == 0 && WS_XB % 256 == 0 && WS_RSS % 256 == 0, "ws alignment");

constexpr int LDS_BYTES = 147456, LDS_X = 131072;

struct Params {
    const float *x_prompt, *x_sample, *mem_prompt, *cache_k, *cache_v, *st_a, *st_b, *st_p, *norm_mix, *norm_mem, *w_kv, *w_in, *conv_a_w, *conv_b_w, *conv_b_bias,
        *ln_g, *ln_b, *pool_w, *pool_scale, *gate_bias, *w_o, *norm_ffn, *w_ff1, *w_ff2, *norm_final;
    float* out; unsigned char* ws;
};

__device__ __forceinline__ unsigned cvt_pk_bf16(float lo, float hi) { unsigned r; asm("v_cvt_pk_bf16_f32 %0, %1, %2" : "=v"(r) : "v"(lo), "v"(hi)); return r; }
__device__ __forceinline__ float bf_lo(unsigned w) { return __uint_as_float(w << 16); }
__device__ __forceinline__ float bf_hi(unsigned w) { return __uint_as_float(w & 0xffff0000u); }
__device__ __forceinline__ float sigm(float x) { return __builtin_amdgcn_rcpf(1.0f + __builtin_amdgcn_exp2f(-1.44269504f * x)); }
__device__ __forceinline__ int win_src_col(int n) { if (n >= C_PIN) return n; if (n >= C_G1) { const int q = n - C_G1, t = q >> 8, r = q & 255; return r < 128 ? C_G1 + 128 * t + r : C_G2 + 128 * t + (r - 128); } if (n >= 2048) return C_BA + (n - 2048); const int t = n >> 8, r = n & 255; return r < 128 ? C_HA + 128 * t + r : C_CA + 128 * t + (r - 128); }
__device__ __forceinline__ float wave_sum(float v) {
#pragma unroll
    for (int o = 1; o < 64; o <<= 1) v += __shfl_xor(v, o);
    return v;
}
__device__ __forceinline__ float wave_sum_dpp(float v) {
    v += __int_as_float(__builtin_amdgcn_update_dpp(0, __float_as_int(v), 0x128, 0xf, 0xf, false));
    v += __int_as_float(__builtin_amdgcn_update_dpp(0, __float_as_int(v), 0x124, 0xf, 0xf, false));
    v += __int_as_float(__builtin_amdgcn_update_dpp(0, __float_as_int(v), 0x122, 0xf, 0xf, false));
    v += __int_as_float(__builtin_amdgcn_update_dpp(0, __float_as_int(v), 0x121, 0xf, 0xf, false));
    const int iv = __float_as_int(v);
    return (__int_as_float(__builtin_amdgcn_readlane(iv, 0)) + __int_as_float(__builtin_amdgcn_readlane(iv, 16))) + (__int_as_float(__builtin_amdgcn_readlane(iv, 32)) + __int_as_float(__builtin_amdgcn_readlane(iv, 48)));
}
#define LDS_WAIT() asm volatile("s_waitcnt lgkmcnt(0)" ::: "memory")
#define LDS_BARRIER() do { asm volatile("s_waitcnt lgkmcnt(0)" ::: "memory"); __builtin_amdgcn_s_barrier(); asm volatile("" ::: "memory"); } while (0)
__device__ __forceinline__ int fresh_lane() { int l; asm volatile("v_mbcnt_lo_u32_b32 %0, -1, 0\n\tv_mbcnt_hi_u32_b32 %0, -1, %0" : "=v"(l)); return l; }

#define XB_TMO      128
#define XB_XCNT(j)  (256  + 64 * (j))
#define XB_XSUB(j)  (1280 + 64 * (j))
#define XB_XGEN(j)  (2304 + 64 * (j))
#define XB_TOP      3328
#define XB_TOPGEN   3392
#define XCD_BAR_WORDS 3456
#define XB_SPIN_CAP (1u << 22)
__device__ __forceinline__ unsigned xb_ld(unsigned* p)              { return __hip_atomic_load(p, __ATOMIC_RELAXED, __HIP_MEMORY_SCOPE_AGENT); }
__device__ __forceinline__ unsigned xb_add(unsigned* p, unsigned v) { return __hip_atomic_fetch_add(p, v, __ATOMIC_RELAXED, __HIP_MEMORY_SCOPE_AGENT); }
__device__ __forceinline__ unsigned xb_xcc_id() { return (unsigned)__builtin_amdgcn_s_getreg((3 << 11) | 20) & 0xFu; }
#define XB_SPIN(cond, bar) do { unsigned _sp = 0; while (cond) { __builtin_amdgcn_s_sleep(1); \
    if ((++_sp & 255u) == 0u) { if (xb_ld(&(bar)[XB_TMO])) break; if (_sp > XB_SPIN_CAP) { atomicAdd(&(bar)[XB_TMO], 1u); break; } } } } while (0)
struct XcdBarrier { unsigned* bar; unsigned x; volatile LAS unsigned* st; };
__device__ __forceinline__ XcdBarrier xcd_barrier_post(unsigned* bar, volatile LAS unsigned* st) {
    XcdBarrier b; b.bar = bar; b.x = xb_xcc_id(); b.st = st;
    if (threadIdx.x == 0) (void)xb_add(&bar[XB_XCNT(b.x)], 1u);
    return b;
}
__device__ __forceinline__ void xcd_barrier_complete(unsigned* bar, unsigned x, unsigned& nloc, unsigned& nx) {
    const unsigned G = gridDim.x * gridDim.y * gridDim.z;
    unsigned sum, cnt, mine, sp = 0u;
    for (;;) {
        sum = 0u; cnt = 0u; mine = 0u;
#pragma unroll
        for (unsigned j = 0; j < 16; ++j) { const unsigned c = xb_ld(&bar[XB_XCNT(j)]); sum += c; cnt += (c > 0u) ? 1u : 0u; mine = (j == x) ? c : mine; }
        if (sum == G) break;
        __builtin_amdgcn_s_sleep(1);
        if ((++sp & 255u) == 0u) { if (xb_ld(&bar[XB_TMO])) break; if (sp > XB_SPIN_CAP) { atomicAdd(&bar[XB_TMO], 1u); break; } }
    }
    nloc = mine > 0u ? mine : 1u; nx = cnt > 0u ? cnt : 1u;
}
__device__ __forceinline__ void xcd_barrier(const XcdBarrier& b) {
    asm volatile("s_waitcnt vmcnt(0)" ::: "memory");
    __syncthreads();
    if (threadIdx.x == 0) {
        unsigned* bar = b.bar;
        unsigned xid = b.x; asm volatile("" : "+s"(xid));
        __builtin_amdgcn_s_waitcnt(0);
        unsigned nloc = b.st[0], nx = b.st[1];
        if (nloc == 0u) { xcd_barrier_complete(bar, xid, nloc, nx); b.st[0] = nloc; b.st[1] = nx; }
        const unsigned old = xb_add(&bar[XB_XSUB(xid)], 1u);
        const unsigned gen = old / nloc;
        if (old + 1u == (gen + 1u) * nloc) {
            __builtin_amdgcn_fence(__ATOMIC_RELEASE, "agent");
            asm volatile("s_waitcnt vmcnt(0)" ::: "memory");
            const unsigned og = xb_add(&bar[XB_TOP], 1u);
            const unsigned tg = og / nx;
            if (og + 1u == (tg + 1u) * nx) xb_add(&bar[XB_TOPGEN], 1u);
            else XB_SPIN(xb_ld(&bar[XB_TOPGEN]) == tg, bar);
            __builtin_amdgcn_fence(__ATOMIC_ACQUIRE, "agent");
            xb_add(&bar[XB_XGEN(xid)], 1u);
            asm volatile("s_waitcnt vmcnt(0)" ::: "memory");
        } else {
            XB_SPIN(xb_ld(&bar[XB_XGEN(xid)]) == gen, bar);
            __builtin_amdgcn_fence(__ATOMIC_ACQUIRE, "agent");
            asm volatile("s_waitcnt vmcnt(0)" ::: "memory");
        }
    }
    __syncthreads();
}

namespace pg8 {
constexpr int BM = 256, BK = 64, HALF = 128, HTB = HALF * BK * 2, NXCD = 8, WGM = 8;
__host__ __device__ __forceinline__ int lds_byte(int r, int c) { const int st = (r >> 4) * 2 + (c >> 5), rr = r & 15, cc = c & 31, ob = rr * 64 + cc * 2; return st * 1024 + (ob ^ (((ob >> 9) & 1) << 5)); }
__host__ __device__ __forceinline__ void stage_rc(int b, int& R, int& C) { const int st = b / 1024, sb = b % 1024, swz = sb ^ (((sb >> 9) & 1) << 5); R = (st >> 1) * 16 + swz / 64; C = (st & 1) * 32 + (swz % 64) / 2; }
__host__ __device__ __forceinline__ int perm32(int rho) { const int n = rho >> 4, i = rho & 15; return 8 * (i >> 2) + 4 * n + (i & 3); }
struct Unit { int pm, pn, ty; };
struct StaticOrder {
    int nM, nN, nwg, G, c;
    __device__ __forceinline__ void init(int nM_, int nN_, int G_, int c_) { nM = nM_; nN = nN_; nwg = nM * nN; G = G_; c = c_; }
    __device__ __forceinline__ bool next(int i, Unit& u) const {
        const long L = (long)i * G + c; if (L >= nwg) return false;
        int wgid = (int)L; { const int q = nwg / NXCD, r = nwg % NXCD, xcd = wgid % NXCD, off = wgid / NXCD; wgid = (xcd < r ? xcd * (q + 1) : r * (q + 1) + (xcd - r) * q) + off; }
        const int nig = WGM * nN, gid = wgid / nig, fm = gid * WGM, gsz = (nM - fm) < WGM ? (nM - fm) : WGM;
        u.pm = fm + ((wgid % nig) % gsz); u.pn = (wgid % nig) / gsz; u.ty = 0; return true;
    }
};
template <class Prob, class Epi, class Sched>
__device__ __forceinline__ void gemm_phase(LAS unsigned char* lds, const Prob& P, const Sched& S, const Epi& E, const int wave_sgpr) {
    const int wid = wave_sgpr, lane = fresh_lane(), tid = wid * 64 + lane,
        wr = wid >> 2, wc = wid & 3, fr = lane & 15, fq = lane >> 4;
    const int K = P.K, nt = K / BK, lda = P.lda, ldb = P.ldb;
    unsigned voffA[2], voffB[2];
#pragma unroll
    for (int i = 0; i < 2; ++i) { int R, C; stage_rc(tid * 16 + i * 8192, R, C); const int Rb = (R & ~31) + perm32(R & 31);
        voffA[i] = (unsigned)(R * lda + C) * 2u; voffB[i] = (unsigned)(Rb * ldb + C) * 2u; }
    const size_t kstep = (size_t)(BK * 2);
    const size_t hstepA = (size_t)HALF * lda * 2, hstepB = (size_t)HALF * ldb * 2;
    const unsigned ldsw = (unsigned)wid * 1024u;
    const int aoff = lds_byte(wr * 64 + fr, fq * 8), boff = lds_byte(wc * 32 + fr, fq * 8);
#define PG8_SA(b, h) (((b) * 2 + (h)) * HTB)
#define PG8_SB(b, h) ((4 + (b) * 2 + (h)) * HTB)
#define PG8_STAGE(bufoff, gbase, voff) do { _Pragma("unroll") for (int _i = 0; _i < 2; ++_i) \
        __builtin_amdgcn_global_load_lds((const unsigned*)((const char*)(gbase) + (voff)[_i]), (LAS unsigned*)(lds + (bufoff) + ldsw + _i * 8192), 16, 0, 0); } while (0)
#define PG8_LDA(dst, b, h) do { _Pragma("unroll") for (int m = 0; m < 4; ++m) _Pragma("unroll") for (int k = 0; k < 2; ++k) dst[m][k] = *(const LAS bf16x8*)(lds + PG8_SA(b, h) + aoff + m * 2048 + k * 1024); } while (0)
#define PG8_LDB(dst, b, h) do { _Pragma("unroll") for (int n = 0; n < 2; ++n) _Pragma("unroll") for (int k = 0; k < 2; ++k) dst[n][k] = *(const LAS bf16x8*)(lds + PG8_SB(b, h) + boff + n * 2048 + k * 1024); } while (0)
#define PG8_MMA(ai, bj, At, Bt) do { __builtin_amdgcn_s_setprio(1); _Pragma("unroll") for (int m = 0; m < 4; ++m) _Pragma("unroll") for (int n = 0; n < 2; ++n) _Pragma("unroll") for (int k = 0; k < 2; ++k) \
        acc[ai][bj][m][n] = __builtin_amdgcn_mfma_f32_16x16x32_bf16(Bt[n][k], At[m][k], acc[ai][bj][m][n], 0, 0, 0); __builtin_amdgcn_s_setprio(0); } while (0)
#define PG8_WAIT_V(n) asm volatile("s_waitcnt vmcnt(" #n ")" ::: "memory")
#define PG8_WAIT_L(n) asm volatile("s_waitcnt lgkmcnt(" #n ")" ::: "memory")
#define PG8_BAR __builtin_amdgcn_s_barrier()
#define PG8_SCHED __builtin_amdgcn_sched_barrier(0)
    Unit cur, nxt; int ui = 0;
    if (!S.next(0, cur)) return;
    f32x4 acc[2][2][4][2];
#pragma unroll
    for (int a = 0; a < 2; ++a)
#pragma unroll
        for (int b = 0; b < 2; ++b)
#pragma unroll
            for (int m = 0; m < 4; ++m)
#pragma unroll
                for (int n = 0; n < 2; ++n) acc[a][b][m][n] = (f32x4){0.f, 0.f, 0.f, 0.f};
    bf16x8 At[4][2], B0[2][2], B1[2][2];
    const char* cA = P.a_base(cur); const char* cB = P.b_base(cur);
    int tbuf = 0;
    if constexpr (Epi::USES_RSTD) { if (tid < 256) {
        const f32x4* q = (const f32x4*)(E.rss + (size_t)(cur.pm * 256 + tid) * 16); const f32x4 t0 = q[0], t1 = q[1], t2 = q[2], t3 = q[3];
        ((LAS float*)(lds + LDS_X + 9216))[tid] = rsqrtf((((t0.x + t0.y) + (t0.z + t0.w)) + ((t1.x + t1.y) + (t1.z + t1.w)) + ((t2.x + t2.y) + (t2.z + t2.w)) + ((t3.x + t3.y) + (t3.z + t3.w))) * (1.0f / D) + EPS); } }
    PG8_STAGE(PG8_SB(0, 0), cB, voffB); PG8_STAGE(PG8_SB(0, 1), cB + hstepB, voffB); PG8_STAGE(PG8_SA(0, 0), cA, voffA); PG8_STAGE(PG8_SA(0, 1), cA + hstepA, voffA);
    if (wr == 1) PG8_BAR;
    PG8_WAIT_V(2); PG8_BAR;
    PG8_STAGE(PG8_SB(1, 0), cB + kstep, voffB); PG8_STAGE(PG8_SA(1, 0), cA + kstep, voffA); PG8_STAGE(PG8_SB(1, 1), cB + hstepB + kstep, voffB);
    PG8_WAIT_V(6); PG8_BAR;
    for (;;) {
        const bool has_next = S.next(ui + 1, nxt);
        const char* nA = has_next ? P.a_base(nxt) : cA; const char* nB = has_next ? P.b_base(nxt) : cB;
        for (int t = 0; t < nt; t += 2) {
            const bool last = (t == nt - 2);
            const char* a1 = cA + (size_t)(t + 1) * kstep;
            const char* a2 = last ? nA : cA + (size_t)(t + 2) * kstep; const char* b2 = last ? nB : cB + (size_t)(t + 2) * kstep;
            const char* a3 = a2 + kstep; const char* b3 = b2 + kstep;
            PG8_LDB(B0, 0, 0); PG8_LDB(B1, 0, 1); PG8_SCHED; PG8_LDA(At, 0, 0); PG8_STAGE(PG8_SA(1, 1), a1 + hstepA, voffA);
            PG8_WAIT_V(8); PG8_WAIT_L(0); PG8_BAR; PG8_MMA(0, 0, At, B0); PG8_MMA(0, 1, At, B1); PG8_BAR; PG8_SCHED;
            PG8_LDA(At, 0, 1); PG8_STAGE(PG8_SB(0, 0), b2, voffB); PG8_STAGE(PG8_SB(0, 1), b2 + hstepB, voffB); PG8_STAGE(PG8_SA(0, 0), a2, voffA);
            PG8_WAIT_V(8); PG8_WAIT_L(0); PG8_BAR; PG8_MMA(1, 0, At, B0); PG8_MMA(1, 1, At, B1); PG8_BAR; PG8_SCHED;
            PG8_LDB(B0, 1, 0); PG8_LDB(B1, 1, 1); PG8_SCHED; PG8_LDA(At, 1, 0); PG8_STAGE(PG8_SA(0, 1), a2 + hstepA, voffA);
            PG8_WAIT_V(8); PG8_WAIT_L(0); PG8_BAR; PG8_MMA(0, 0, At, B0); PG8_MMA(0, 1, At, B1); PG8_BAR; PG8_SCHED;
            PG8_LDA(At, 1, 1); PG8_STAGE(PG8_SB(1, 0), b3, voffB); PG8_STAGE(PG8_SB(1, 1), b3 + hstepB, voffB); PG8_STAGE(PG8_SA(1, 0), a3, voffA);
            PG8_WAIT_V(8); PG8_WAIT_L(0); PG8_BAR; PG8_MMA(1, 0, At, B0); PG8_MMA(1, 1, At, B1); PG8_BAR; PG8_SCHED;
        }
        if (wr == 0) PG8_BAR;
        f32x4 nx0, nx1, nx2, nx3;
        if constexpr (Epi::USES_RSTD) { if (has_next && tid < 256) { const f32x4* q = (const f32x4*)(E.rss + (size_t)(nxt.pm * 256 + tid) * 16); nx0 = q[0]; nx1 = q[1]; nx2 = q[2]; nx3 = q[3]; } }
        E(acc, cur, wr, wc, fr, fq, lds, tbuf);
        if constexpr (Epi::USES_RSTD) { if (has_next && tid < 256)
            ((LAS float*)(lds + LDS_X + 9216))[(tbuf ^ 1) * 256 + tid] = rsqrtf((((nx0.x + nx0.y) + (nx0.z + nx0.w)) + ((nx1.x + nx1.y) + (nx1.z + nx1.w)) + ((nx2.x + nx2.y) + (nx2.z + nx2.w)) + ((nx3.x + nx3.y) + (nx3.z + nx3.w))) * (1.0f / D) + EPS);
            tbuf ^= 1; }
        if (!has_next) break;
#pragma unroll
        for (int a = 0; a < 2; ++a)
#pragma unroll
            for (int b = 0; b < 2; ++b)
#pragma unroll
                for (int m = 0; m < 4; ++m)
#pragma unroll
                    for (int n = 0; n < 2; ++n) acc[a][b][m][n] = (f32x4){0.f, 0.f, 0.f, 0.f};
        cur = nxt; cA = nA; cB = nB; ++ui;
        if (wr == 1) PG8_BAR;
    }
    PG8_WAIT_V(0);
    PG8_BAR;
#undef PG8_SA
#undef PG8_SB
#undef PG8_STAGE
#undef PG8_LDA
#undef PG8_LDB
#undef PG8_MMA
#undef PG8_WAIT_V
#undef PG8_WAIT_L
#undef PG8_BAR
#undef PG8_SCHED
}
}
using pg8::Unit;
typedef f32x4 Acc[2][2][4][2];

struct ProbStd { const char* A; const char* B; int lda, ldb, K;
    __device__ __forceinline__ const char* a_base(const Unit& u) const { return A + (size_t)u.pm * 256 * lda * 2; }
    __device__ __forceinline__ const char* b_base(const Unit& u) const { return B + (size_t)u.pn * 256 * ldb * 2; } };
struct ProbS { const char* PROJ; const char* KB; int lda, ldb, K;
    __device__ __forceinline__ const char* a_base(const Unit& u) const { return PROJ + ((size_t)u.pm * 256 * NPROJ + C_Q + u.pn * 256) * 2; }
    __device__ __forceinline__ const char* b_base(const Unit& u) const { return KB + ((size_t)((u.pm >> 3) * 256) * D + u.pn * 256) * 2; } };
struct ProbMerge { const char* PL; const char* WP; long dA, dB; int lda, ldb, K;
    __device__ __forceinline__ const char* a_base(const Unit& u) const { return PL + (long)u.ty * dA + ((size_t)u.pm * 256 * D + u.pn * 256) * 2; }
    __device__ __forceinline__ const char* b_base(const Unit& u) const { return WP + (long)u.ty * dB + (size_t)(u.ty * (u.pm >> 3) * 4 + u.pn) * 65536 * 2; } };
struct OrderS { int G, c;
    __device__ __forceinline__ bool next(int i, Unit& u) const { const int L = i * G + c; if (L >= 256) return false; u.pm = L >> 2; u.pn = L & 3; u.ty = 0; return true; } };
struct OrderMerge { int G, c;
    __device__ __forceinline__ bool next(int i, Unit& u) const {
        const int k = i >> 1, sub = i & 1, T = k * G + c; if (T >= 256) return false;
        u.pm = T >> 2; u.pn = T & 3; u.ty = sub; return true; } };

__device__ __forceinline__ void row_rstd8(const float* rss, int rowbase, int fq, float (&rs)[2][4]) {
    f32x4 t[2][4];
#pragma unroll
    for (int ai = 0; ai < 2; ++ai)
#pragma unroll
        for (int m = 0; m < 4; ++m) t[ai][m] = *(const f32x4*)(rss + (size_t)(rowbase + ai * 128 + m * 16) * 16 + fq * 4);
#pragma unroll
    for (int ai = 0; ai < 2; ++ai)
#pragma unroll
        for (int m = 0; m < 4; ++m) { float s = (t[ai][m].x + t[ai][m].y) + (t[ai][m].z + t[ai][m].w); s += __shfl_xor(s, 16); s += __shfl_xor(s, 32); rs[ai][m] = rsqrtf(s * (1.0f / D) + EPS); }
}
struct EpiKV {
    static constexpr bool USES_RSTD = false; static constexpr const float* rss = nullptr;
    float* out; bf16_t* KB; bf16_t* VT; const float* rsm;
    __device__ __forceinline__ void operator()(Acc& acc, const Unit& u, int wr, int wc, int fr, int fq, LAS unsigned char*, int) const {
        const int l = u.pn >> 3, pnl = u.pn & 7, isV = pnl >> 2, hh = pnl & 3;
        const int row0 = u.pm * 256 + wr * 64 + fr, cl0 = wc * 32 + 8 * fq;
        float* ob = out + (isV ? OUT_MV : OUT_MK) + (size_t)l * 2048 * D;
#pragma unroll
        for (int ai = 0; ai < 2; ++ai)
#pragma unroll
            for (int m = 0; m < 4; ++m) { const int row = row0 + ai * 128 + m * 16; const float rs = rsqrtf(rsm[row] * (1.0f / D) + EPS);
#pragma unroll
                for (int bj = 0; bj < 2; ++bj) { const int dcol = bj * 128 + cl0, ck = hh * 256 + dcol; const f32x4 v0 = acc[ai][bj][m][0] * rs, v1 = acc[ai][bj][m][1] * rs;
                    float* op = ob + (size_t)row * D + ck; *(f32x4*)op = v0; *(f32x4*)(op + 4) = v1;
                    if (!isV) { u32x4 w; w.x = cvt_pk_bf16(v0[0], v0[1]); w.y = cvt_pk_bf16(v0[2], v0[3]); w.z = cvt_pk_bf16(v1[0], v1[1]); w.w = cvt_pk_bf16(v1[2], v1[3]);
                        *(u32x4*)(KB + ((size_t)l * 2048 + row) * D + ck) = w; }
                    else { bf16_t* vp = VT + ((size_t)((l * 8 + (row >> 8)) * 4 + hh) * 256 + dcol) * 256 + (row & 255);
#pragma unroll
                        for (int e = 0; e < 4; ++e) { vp[(size_t)e * 256] = (bf16_t)(cvt_pk_bf16(v0[e], 0.f) & 0xffffu); vp[(size_t)(e + 4) * 256] = (bf16_t)(cvt_pk_bf16(v1[e], 0.f) & 0xffffu); } } } }
    }
};
struct EpiProj {
    static constexpr bool USES_RSTD = true; bf16_t* O; int ldc; const float* rss;
    __device__ __forceinline__ void operator()(Acc& acc, const Unit& u, int wr, int wc, int fr, int fq, LAS unsigned char* lds, int tbuf) const {
        const int row0 = u.pm * 256 + wr * 64 + fr, col0 = u.pn * 256 + wc * 32 + 8 * fq;
        const LAS float* T = (const LAS float*)(lds + LDS_X + 9216) + tbuf * 256 + wr * 64 + fr;
        const int dcol0 = win_src_col(u.pn * 256) + wc * 32 + 8 * fq;
        if (u.pn < 8) {
            const int ucol = C_HA + u.pn * 128 + wc * 32 + 8 * fq;
#pragma unroll
            for (int ai = 0; ai < 2; ++ai)
#pragma unroll
                for (int m = 0; m < 4; ++m) { const float r = T[ai * 128 + m * 16], r2 = r * r;
                    const f32x4 p0 = acc[ai][0][m][0] * acc[ai][1][m][0] * r2, p1 = acc[ai][0][m][1] * acc[ai][1][m][1] * r2;
                    u32x4 w; w.x = cvt_pk_bf16(p0[0], p0[1]); w.y = cvt_pk_bf16(p0[2], p0[3]); w.z = cvt_pk_bf16(p1[0], p1[1]); w.w = cvt_pk_bf16(p1[2], p1[3]);
                    __builtin_nontemporal_store(w, (u32x4*)(O + (size_t)(row0 + ai * 128 + m * 16) * ldc + ucol)); }
            return; }
        if (u.pn >= 12 && u.pn < 20) {
            const int gcol = C_G1 + (u.pn - 12) * 128 + wc * 32 + 8 * fq;
#pragma unroll
            for (int ai = 0; ai < 2; ++ai)
#pragma unroll
                for (int m = 0; m < 4; ++m) { const float r = T[ai * 128 + m * 16];
                    const f32x4 a0 = acc[ai][0][m][0] * r, a1 = acc[ai][0][m][1] * r, b0 = acc[ai][1][m][0] * r, b1 = acc[ai][1][m][1] * r;
                    u32x4 w; w.x = cvt_pk_bf16(a0[0] * sigm(b0[0]), a0[1] * sigm(b0[1])); w.y = cvt_pk_bf16(a0[2] * sigm(b0[2]), a0[3] * sigm(b0[3]));
                    w.z = cvt_pk_bf16(a1[0] * sigm(b1[0]), a1[1] * sigm(b1[1])); w.w = cvt_pk_bf16(a1[2] * sigm(b1[2]), a1[3] * sigm(b1[3]));
                    __builtin_nontemporal_store(w, (u32x4*)(O + (size_t)(row0 + ai * 128 + m * 16) * ldc + gcol)); }
            return; }
#pragma unroll
        for (int ai = 0; ai < 2; ++ai)
#pragma unroll
            for (int m = 0; m < 4; ++m) { bf16_t* rowp = O + (size_t)(row0 + ai * 128 + m * 16) * ldc + dcol0; const float r = T[ai * 128 + m * 16];
#pragma unroll
                for (int bj = 0; bj < 2; ++bj) { const f32x4 v0 = acc[ai][bj][m][0] * r, v1 = acc[ai][bj][m][1] * r;
                    u32x4 w; w.x = cvt_pk_bf16(v0[0], v0[1]); w.y = cvt_pk_bf16(v0[2], v0[3]); w.z = cvt_pk_bf16(v1[0], v1[1]); w.w = cvt_pk_bf16(v1[2], v1[3]);
                    if (u.pn < 36) __builtin_nontemporal_store(w, (u32x4*)(rowp + bj * 128)); else *(u32x4*)(rowp + bj * 128) = w; } }
    }
};
struct EpiFF1 {
    static constexpr bool USES_RSTD = true; bf16_t* O; const float* rss;
    __device__ __forceinline__ void operator()(Acc& acc, const Unit& u, int wr, int wc, int fr, int fq, LAS unsigned char* lds, int tbuf) const {
        const int row0 = u.pm * 256 + wr * 64 + fr, col0 = u.pn * 256 + wc * 32 + 8 * fq;
        const LAS float* T = (const LAS float*)(lds + LDS_X + 9216) + tbuf * 256 + wr * 64 + fr;
#pragma unroll
        for (int ai = 0; ai < 2; ++ai)
#pragma unroll
            for (int m = 0; m < 4; ++m) { bf16_t* rowp = O + (size_t)(row0 + ai * 128 + m * 16) * DFF + col0; const float r = T[ai * 128 + m * 16];
#pragma unroll
                for (int bj = 0; bj < 2; ++bj) { f32x4 v0 = acc[ai][bj][m][0] * r, v1 = acc[ai][bj][m][1] * r;
#pragma unroll
                    for (int e = 0; e < 4; ++e) { const float a = fmaxf(v0[e], 0.f), b = fmaxf(v1[e], 0.f); v0[e] = a * a; v1[e] = b * b; }
                    u32x4 w; w.x = cvt_pk_bf16(v0[0], v0[1]); w.y = cvt_pk_bf16(v0[2], v0[3]); w.z = cvt_pk_bf16(v1[0], v1[1]); w.w = cvt_pk_bf16(v1[2], v1[3]);
                    *(u32x4*)(rowp + bj * 128) = w; } }
    }
};
struct EpiRes {
    static constexpr bool USES_RSTD = false;
    const float* xin_p; bf16_t* XB; float* rss;
    __device__ __forceinline__ void operator()(Acc& acc, const Unit& u, int wr, int wc, int fr, int fq, LAS unsigned char*, int) const {
        const int row0 = u.pm * 256 + wr * 64 + fr, col0 = u.pn * 256 + wc * 32 + 8 * fq;
#pragma unroll
        for (int ai = 0; ai < 2; ++ai) {
            f32x4 r[4][2][2];
            if (xin_p) {
#pragma unroll
                for (int m = 0; m < 4; ++m)
#pragma unroll
                    for (int bj = 0; bj < 2; ++bj) { const float* sp = xin_p + (size_t)(row0 + ai * 128 + m * 16) * D + col0 + bj * 128; r[m][bj][0] = *(const f32x4*)sp; r[m][bj][1] = *(const f32x4*)(sp + 4); }
            } else {
                u32x4 rb[4][2];
#pragma unroll
                for (int m = 0; m < 4; ++m)
#pragma unroll
                    for (int bj = 0; bj < 2; ++bj) rb[m][bj] = *(const u32x4*)(XB + (size_t)(row0 + ai * 128 + m * 16) * D + col0 + bj * 128);
#pragma unroll
                for (int m = 0; m < 4; ++m)
#pragma unroll
                    for (int bj = 0; bj < 2; ++bj) { const u32x4 q = rb[m][bj]; r[m][bj][0] = (f32x4){bf_lo(q.x), bf_hi(q.x), bf_lo(q.y), bf_hi(q.y)}; r[m][bj][1] = (f32x4){bf_lo(q.z), bf_hi(q.z), bf_lo(q.w), bf_hi(q.w)}; }
            }
#pragma unroll
            for (int m = 0; m < 4; ++m) { const int row = row0 + ai * 128 + m * 16; float ss = 0.f;
#pragma unroll
                for (int bj = 0; bj < 2; ++bj) { const int col = col0 + bj * 128;
                    const f32x4 v0 = r[m][bj][0] + acc[ai][bj][m][0], v1 = r[m][bj][1] + acc[ai][bj][m][1];
                    u32x4 w; w.x = cvt_pk_bf16(v0[0], v0[1]); w.y = cvt_pk_bf16(v0[2], v0[3]); w.z = cvt_pk_bf16(v1[0], v1[1]); w.w = cvt_pk_bf16(v1[2], v1[3]);
                    *(u32x4*)(XB + (size_t)row * D + col) = w;
                    ss += (v0[0] * v0[0] + v0[1] * v0[1]) + (v0[2] * v0[2] + v0[3] * v0[3]) + (v1[0] * v1[0] + v1[1] * v1[1]) + (v1[2] * v1[2] + v1[3] * v1[3]); }
                ss += __shfl_xor(ss, 16); ss += __shfl_xor(ss, 32);
                if (fq == 0) rss[(size_t)row * 16 + u.pn * 4 + wc] = ss; }
        }
    }
};
struct EpiS {
    static constexpr bool USES_RSTD = false; static constexpr const float* rss = nullptr;
    bf16_t* PP;
    __device__ __forceinline__ void operator()(Acc& acc, const Unit& u, int wr, int wc, int fr, int fq, LAS unsigned char* lds, int tbuf) const {
        LAS float* TM = (LAS float*)(lds + LDS_X); LAS float* TS = (LAS float*)(lds + LDS_X + 4096);
        const float sc = 0.0625f * 1.44269504f;
#pragma unroll
        for (int ai = 0; ai < 2; ++ai)
#pragma unroll
            for (int m = 0; m < 4; ++m) { float v = -3.0e38f;
#pragma unroll
                for (int bj = 0; bj < 2; ++bj)
#pragma unroll
                    for (int n = 0; n < 2; ++n) { const f32x4 x = acc[ai][bj][m][n]; v = fmaxf(v, fmaxf(fmaxf(x[0], x[1]), fmaxf(x[2], x[3]))); }
                v = fmaxf(v, __shfl_xor(v, 16)); v = fmaxf(v, __shfl_xor(v, 32));
                if (fq == 0) TM[(ai * 128 + wr * 64 + m * 16 + fr) * 4 + wc] = v; }
        LDS_WAIT(); __builtin_amdgcn_s_barrier(); asm volatile("" ::: "memory");
#pragma unroll
        for (int ai = 0; ai < 2; ++ai)
#pragma unroll
            for (int m = 0; m < 4; ++m) { const int rl = ai * 128 + wr * 64 + m * 16 + fr; const f32x4 t = *(const LAS f32x4*)(TM + rl * 4);
                const float gm = fmaxf(fmaxf(t[0], t[1]), fmaxf(t[2], t[3])) * sc; float s = 0.f;
#pragma unroll
                for (int bj = 0; bj < 2; ++bj)
#pragma unroll
                    for (int n = 0; n < 2; ++n) { f32x4 x = acc[ai][bj][m][n];
#pragma unroll
                        for (int e = 0; e < 4; ++e) { x[e] = __builtin_amdgcn_exp2f(x[e] * sc - gm); s += x[e]; }
                        acc[ai][bj][m][n] = x; }
                s += __shfl_xor(s, 16); s += __shfl_xor(s, 32);
                if (fq == 0) TS[rl * 4 + wc] = s; }
        LDS_WAIT(); __builtin_amdgcn_s_barrier(); asm volatile("" ::: "memory");
        const int row0 = u.pm * 256 + wr * 64 + fr, col0 = u.pn * 256 + wc * 32 + 8 * fq;
#pragma unroll
        for (int ai = 0; ai < 2; ++ai)
#pragma unroll
            for (int m = 0; m < 4; ++m) { const int rl = ai * 128 + wr * 64 + m * 16 + fr; const f32x4 t = *(const LAS f32x4*)(TS + rl * 4);
                const float inv = 1.0f / ((t[0] + t[1]) + (t[2] + t[3])); bf16_t* rowp = PP + (size_t)(row0 + ai * 128 + m * 16) * D + col0;
#pragma unroll
                for (int bj = 0; bj < 2; ++bj) { const f32x4 v0 = acc[ai][bj][m][0] * inv, v1 = acc[ai][bj][m][1] * inv;
                    u32x4 w; w.x = cvt_pk_bf16(v0[0], v0[1]); w.y = cvt_pk_bf16(v0[2], v0[3]); w.z = cvt_pk_bf16(v1[0], v1[1]); w.w = cvt_pk_bf16(v1[2], v1[3]);
                    *(u32x4*)(rowp + bj * 128) = w; } }
    }
};
struct EpiMerge {
    static constexpr bool USES_RSTD = false; static constexpr const float* rss = nullptr;
    const bf16_t* E; bf16_t* MG; const bf16_t* PROJ; const float* gbias;
    __device__ __forceinline__ void operator()(Acc& acc, const Unit& u, int wr, int wc, int fr, int fq, LAS unsigned char*, int) const {
        const int row0 = u.pm * 256 + wr * 64 + fr, col0 = u.pn * 256 + wc * 32 + 8 * fq;
        const int gsel = 2 + u.ty;
        const bf16_t* bsrc = E + (long)u.ty * (long)((const bf16_t*)MG - E);
        f32x4 gb[2][2];
#pragma unroll
        for (int bj = 0; bj < 2; ++bj) { gb[bj][0] = *(const f32x4*)(gbias + gsel * D + col0 + bj * 128); gb[bj][1] = *(const f32x4*)(gbias + gsel * D + col0 + bj * 128 + 4); }
#pragma unroll
        for (int ai = 0; ai < 2; ++ai) {
            u32x4 bs[4][2], gl[4][2];
#pragma unroll
            for (int m = 0; m < 4; ++m)
#pragma unroll
                for (int bj = 0; bj < 2; ++bj) { const size_t row = (size_t)(row0 + ai * 128 + m * 16); const int col = col0 + bj * 128;
                    bs[m][bj] = *(const u32x4*)(bsrc + row * D + col); gl[m][bj] = *(const u32x4*)(PROJ + row * NPROJ + C_GATE + gsel * D + col); }
#pragma unroll
            for (int m = 0; m < 4; ++m)
#pragma unroll
                for (int bj = 0; bj < 2; ++bj) { const size_t row = (size_t)(row0 + ai * 128 + m * 16); const int col = col0 + bj * 128;
                    const u32x4 base = bs[m][bj], g = gl[m][bj]; const f32x4 gb0 = gb[bj][0], gb1 = gb[bj][1], a0 = acc[ai][bj][m][0], a1 = acc[ai][bj][m][1];
                    float o[8];
                    o[0] = bf_lo(base.x) + sigm(bf_lo(g.x) + gb0[0]) * a0[0]; o[1] = bf_hi(base.x) + sigm(bf_hi(g.x) + gb0[1]) * a0[1];
                    o[2] = bf_lo(base.y) + sigm(bf_lo(g.y) + gb0[2]) * a0[2]; o[3] = bf_hi(base.y) + sigm(bf_hi(g.y) + gb0[3]) * a0[3];
                    o[4] = bf_lo(base.z) + sigm(bf_lo(g.z) + gb1[0]) * a1[0]; o[5] = bf_hi(base.z) + sigm(bf_hi(g.z) + gb1[1]) * a1[1];
                    o[6] = bf_lo(base.w) + sigm(bf_lo(g.w) + gb1[2]) * a1[2]; o[7] = bf_hi(base.w) + sigm(bf_hi(g.w) + gb1[3]) * a1[3];
                    u32x4 w; w.x = cvt_pk_bf16(o[0], o[1]); w.y = cvt_pk_bf16(o[2], o[3]); w.z = cvt_pk_bf16(o[4], o[5]); w.w = cvt_pk_bf16(o[6], o[7]);
                    *(u32x4*)(MG + row * D + col) = w; }
        }
    }
};

template <int CH> __device__ __forceinline__ void sk_load(const bf16_t* Ab, const bf16_t* Bb, int lda, int ldb, bf16x8 (&a)[2][CH], bf16x8 (&b)[2][CH]) {
#pragma unroll
    for (int q = 0; q < CH; ++q) { a[0][q] = *(const bf16x8*)(Ab + q * 32); a[1][q] = *(const bf16x8*)(Ab + (size_t)16 * lda + q * 32);
        b[0][q] = *(const bf16x8*)(Bb + q * 32); b[1][q] = *(const bf16x8*)(Bb + (size_t)16 * ldb + q * 32); }
}
template <int KSTEPS, class SP, class SE>
__device__ __forceinline__ void skinny_gemm(LAS unsigned char* lds, const SP& P, const SE& E, int ntasks, int bxo, int Go, int wid, int tbase = 0) {
    constexpr int CH = KSTEPS < 4 ? KSTEPS : 4, NCH = KSTEPS / CH, KW = KSTEPS * 32;
    const int lane = fresh_lane(), fr = lane & 15, fq = lane >> 4, tid = wid * 64 + lane;
    LAS float* RB = (LAS float*)lds;
    LAS float* PSS = RB + 8 * 16 * 64;
    const int lda = P.lda, ldb = P.ldb;
    const int nmy = bxo < ntasks ? (ntasks - bxo + Go - 1) / Go : 0, nchunks = nmy * NCH;
    if (nchunks == 0) return;
    bf16x8 a[2][CH], b[2][CH], an[2][CH], bn[2][CH];
    { const int t = tbase + bxo, rt = t & 3, ct = t >> 2;
      sk_load<CH>(P.a_ptr(ct) + (size_t)(rt * 32 + fr) * lda + wid * KW + fq * 8, P.b_ptr(ct) + (size_t)fr * ldb + wid * KW + fq * 8, lda, ldb, a, b); }
    f32x4 acc[2][2];
    asm volatile("s_waitcnt vmcnt(0)" ::: "memory");
    int prt = -1; typename SE::RowPre rowpre = {};
#pragma unroll 1
    for (int c = 0; c < nchunks; ++c) {
        const int ti = c / NCH, ch = c % NCH, t = tbase + bxo + ti * Go, rt = t & 3, ct = t >> 2;
        const int erow = rt * 32 + (wid >> 1) * 16 + fr, ecol = ct * 32 + (wid & 1) * 16 + 4 * fq;
        if (wid < 4 && rt != prt) { rowpre = E.prep_row(erow); prt = rt; }
        typename SE::Pre pre;
        if (ch == NCH - 1 && wid < 4) pre = E.prep(erow, ecol);
        if (c + 1 < nchunks) { const int c1 = c + 1, t1 = tbase + bxo + (c1 / NCH) * Go, ch1 = c1 % NCH, rt1 = t1 & 3, ct1 = t1 >> 2;
            sk_load<CH>(P.a_ptr(ct1) + (size_t)(rt1 * 32 + fr) * lda + wid * KW + ch1 * (CH * 32) + fq * 8, P.b_ptr(ct1) + (size_t)fr * ldb + wid * KW + ch1 * (CH * 32) + fq * 8, lda, ldb, an, bn); }
        if (ch == 0) {
#pragma unroll
            for (int i = 0; i < 2; ++i)
#pragma unroll
                for (int j = 0; j < 2; ++j) acc[i][j] = (f32x4){0.f, 0.f, 0.f, 0.f}; }
#pragma unroll
        for (int q = 0; q < CH; ++q) {
            acc[0][0] = __builtin_amdgcn_mfma_f32_16x16x32_bf16(b[0][q], a[0][q], acc[0][0], 0, 0, 0); acc[0][1] = __builtin_amdgcn_mfma_f32_16x16x32_bf16(b[1][q], a[0][q], acc[0][1], 0, 0, 0);
            acc[1][0] = __builtin_amdgcn_mfma_f32_16x16x32_bf16(b[0][q], a[1][q], acc[1][0], 0, 0, 0); acc[1][1] = __builtin_amdgcn_mfma_f32_16x16x32_bf16(b[1][q], a[1][q], acc[1][1], 0, 0, 0); }
        if (ch == NCH - 1) {
#pragma unroll
            for (int i = 0; i < 2; ++i)
#pragma unroll
                for (int j = 0; j < 2; ++j)
#pragma unroll
                    for (int e = 0; e < 4; ++e) RB[(wid * 16 + (i * 2 + j) * 4 + e) * 64 + lane] = acc[i][j][e];
            LDS_BARRIER();
            if (wid < 4) {
                f32x4 v = {0.f, 0.f, 0.f, 0.f};
#pragma unroll
                for (int w = 0; w < 8; ++w)
#pragma unroll
                    for (int e = 0; e < 4; ++e) v[e] += RB[(w * 16 + wid * 4 + e) * 64 + lane];
                const float ss = E(erow, ecol, v, pre, rowpre);
                if (SE::NEED_SS) PSS[((wid >> 1) * 16 + fr) * 8 + (wid & 1) * 4 + fq] = ss;
            }
            LDS_BARRIER();
            if (SE::NEED_SS) { if (tid < 32) { float q = 0.f;
#pragma unroll
                    for (int u = 0; u < 8; ++u) q += PSS[tid * 8 + u];
                    E.store_ss(rt * 32 + tid, ct, q); } }
        }
        if (c + 1 < nchunks) {
#pragma unroll
            for (int i = 0; i < 2; ++i)
#pragma unroll
                for (int q = 0; q < CH; ++q) { a[i][q] = an[i][q]; b[i][q] = bn[i][q]; } }
    }
}
__device__ __forceinline__ float sample_rstd(const float* rsq, int row) {
    const f32x4* q = (const f32x4*)(rsq + row * 32); float s = 0.f;
#pragma unroll
    for (int u = 0; u < 8; ++u) { const f32x4 t = q[u]; s += (t.x + t.y) + (t.z + t.w); }
    return rsqrtf(s * (1.0f / D) + EPS);
}
struct SProbStd { const bf16_t* A; const bf16_t* B; int lda, ldb;
    __device__ __forceinline__ const bf16_t* a_ptr(int) const { return A; }
    __device__ __forceinline__ const bf16_t* b_ptr(int ct) const { return B + (size_t)ct * 32 * ldb; } };
struct SProbPool { const bf16_t* A; const bf16_t* B; int lda, ldb;
    __device__ __forceinline__ const bf16_t* a_ptr(int ct) const { return A + (ct >> 3) * 256; }
    __device__ __forceinline__ const bf16_t* b_ptr(int ct) const { return B + (size_t)ct * 32 * ldb; } };
struct SEpiProj { static constexpr bool NEED_SS = false; typedef int Pre; typedef float RowPre; bf16_t* O; const float* rsq;
    __device__ __forceinline__ RowPre prep_row(int row) const { return sample_rstd(rsq, row); }
    __device__ __forceinline__ Pre prep(int, int) const { return 0; }
    __device__ __forceinline__ float operator()(int row, int col, f32x4 v, Pre, RowPre r) const { v = v * r; col = win_src_col(col);
        u32x2 w; w.x = cvt_pk_bf16(v[0], v[1]); w.y = cvt_pk_bf16(v[2], v[3]); *(u32x2*)(O + ((size_t)MP + row) * NPROJ + col) = w; return 0.f; }
    __device__ __forceinline__ void store_ss(int, int, float) const {} };
struct SEpiFF1 { static constexpr bool NEED_SS = false; typedef int Pre; typedef float RowPre; bf16_t* O; const float* rsq;
    __device__ __forceinline__ RowPre prep_row(int row) const { return sample_rstd(rsq, row); }
    __device__ __forceinline__ Pre prep(int, int) const { return 0; }
    __device__ __forceinline__ float operator()(int row, int col, f32x4 v, Pre, RowPre r) const {
#pragma unroll
        for (int e = 0; e < 4; ++e) { const float a = fmaxf(v[e] * r, 0.f); v[e] = a * a; }
        u32x2 w; w.x = cvt_pk_bf16(v[0], v[1]); w.y = cvt_pk_bf16(v[2], v[3]); *(u32x2*)(O + ((size_t)MP + row) * DFF + col) = w; return 0.f; }
    __device__ __forceinline__ void store_ss(int, int, float) const {} };
struct SEpiRes { static constexpr bool NEED_SS = true; typedef f32x4 Pre; typedef int RowPre; const float* xin_s; bf16_t* XB; float* rsq;
    __device__ __forceinline__ Pre prep(int row, int col) const { if (xin_s) return *(const f32x4*)(xin_s + (size_t)row * D + col);
        const u32x2 q = *(const u32x2*)(XB + ((size_t)MP + row) * D + col); return (f32x4){bf_lo(q.x), bf_hi(q.x), bf_lo(q.y), bf_hi(q.y)}; }
    __device__ __forceinline__ RowPre prep_row(int) const { return 0; }
    __device__ __forceinline__ float operator()(int row, int col, f32x4 v, Pre r, RowPre) const {
        v = v + r;
        u32x2 w; w.x = cvt_pk_bf16(v[0], v[1]); w.y = cvt_pk_bf16(v[2], v[3]); *(u32x2*)(XB + ((size_t)MP + row) * D + col) = w;
        return (v[0] * v[0] + v[1] * v[1]) + (v[2] * v[2] + v[3] * v[3]); }
    __device__ __forceinline__ void store_ss(int row, int ct, float q) const { rsq[row * 32 + ct] = q; } };
struct SEpiMerge { static constexpr bool NEED_SS = false; struct Pre { u32x2 base, g2, g3; f32x4 y; }; typedef int RowPre; const bf16_t* E; bf16_t* MG; const bf16_t* PROJ; const float* gbias; const float* YMS;
    __device__ __forceinline__ Pre prep(int row, int col) const { const size_t gr = (size_t)MP + row; Pre q;
        q.base = *(const u32x2*)(E + gr * D + col); q.g2 = *(const u32x2*)(PROJ + gr * NPROJ + C_GATE + 2 * D + col); q.g3 = *(const u32x2*)(PROJ + gr * NPROJ + C_GATE + 3 * D + col);
        q.y = *(const f32x4*)(YMS + (size_t)row * D + col); return q; }
    __device__ __forceinline__ RowPre prep_row(int) const { return 0; }
    __device__ __forceinline__ float operator()(int row, int col, f32x4 v, const Pre& q, RowPre) const {
        const size_t gr = (size_t)MP + row; const u32x2 base = q.base, g2 = q.g2, g3 = q.g3; const f32x4 y = q.y;
        const f32x4 b2 = *(const f32x4*)(gbias + 2 * D + col), b3 = *(const f32x4*)(gbias + 3 * D + col);
        const float o0 = bf_lo(base.x) + sigm(bf_lo(g2.x) + b2[0]) * v[0] + sigm(bf_lo(g3.x) + b3[0]) * y[0], o1 = bf_hi(base.x) + sigm(bf_hi(g2.x) + b2[1]) * v[1] + sigm(bf_hi(g3.x) + b3[1]) * y[1];
        const float o2 = bf_lo(base.y) + sigm(bf_lo(g2.y) + b2[2]) * v[2] + sigm(bf_lo(g3.y) + b3[2]) * y[2], o3 = bf_hi(base.y) + sigm(bf_hi(g2.y) + b2[3]) * v[3] + sigm(bf_hi(g3.y) + b3[3]) * y[3];
        u32x2 w; w.x = cvt_pk_bf16(o0, o1); w.y = cvt_pk_bf16(o2, o3); *(u32x2*)(MG + gr * D + col) = w; return 0.f; }
    __device__ __forceinline__ void store_ss(int, int, float) const {} };

__device__ __forceinline__ void transpose_item(const float* W, int K, int N, bf16_t* WT, const float* gk, const float* sn, LAS float* scr, int item, int lane, bool remap = false) {
    const int nblk = N / 32, kb = item / nblk, nb = item % nblk, k0 = 64 * kb, n0 = 32 * nb, s0 = remap ? win_src_col(n0) : n0;
    const float snv = sn ? sn[n0 + (lane & 31)] : 1.0f;
    float v[32], g[32];
#pragma unroll
    for (int i = 0; i < 32; ++i) { const int kk = 2 * i + (lane >> 5); v[i] = __builtin_nontemporal_load(W + (size_t)(k0 + kk) * N + s0 + (lane & 31)); g[i] = gk ? gk[k0 + kk] : 1.0f; }
#pragma unroll
    for (int i = 0; i < 32; ++i) { const int kk = 2 * i + (lane >> 5); scr[kk * 33 + (lane & 31)] = v[i] * snv * g[i]; }
    LDS_WAIT(); asm volatile("" ::: "memory");
    const int c = lane & 7;
#pragma unroll
    for (int j = 0; j < 4; ++j) { const int n = (lane >> 3) + 8 * j; const LAS float* s = scr + (8 * c) * 33 + n;
        u32x4 o; o.x = cvt_pk_bf16(s[0 * 33], s[1 * 33]); o.y = cvt_pk_bf16(s[2 * 33], s[3 * 33]); o.z = cvt_pk_bf16(s[4 * 33], s[5 * 33]); o.w = cvt_pk_bf16(s[6 * 33], s[7 * 33]);
        *(u32x4*)(WT + (size_t)(n0 + n) * K + k0 + 8 * c) = o; }
    LDS_WAIT(); asm volatile("" ::: "memory");
}
__device__ __forceinline__ float row_to_bf16(const float* xrow, bf16_t* orow, int lane) {
    f32x4 v[4]; float s = 0.f;
    if (xrow) {
#pragma unroll
        for (int j = 0; j < 4; ++j) { v[j] = *((const f32x4*)xrow + lane + 64 * j); s += (v[j].x * v[j].x + v[j].y * v[j].y) + (v[j].z * v[j].z + v[j].w * v[j].w); }
    } else {
#pragma unroll
        for (int j = 0; j < 4; ++j) v[j] = (f32x4){0.f, 0.f, 0.f, 0.f};
    }
#pragma unroll
    for (int j = 0; j < 4; ++j) { u32x2 w; w.x = cvt_pk_bf16(v[j].x, v[j].y); w.y = cvt_pk_bf16(v[j].z, v[j].w); *((u32x2*)orow + lane + 64 * j) = w; }
    return wave_sum(s);
}

__device__ __forceinline__ void prepass_prompt(const Params& p, int l, int T, const int cont, const int wid, LAS unsigned char* lds, const bf16_t* PROJ, bf16_t* Eb, bf16_t* PL) {
    const int lane = fresh_lane(), tid = wid * 64 + lane;
    const int b = T >> 6, tt = T & 63, t0 = tt * 32, c0 = 2 * tid;
    const bf16_t* PRb = PROJ + (size_t)b * SEQ * NPROJ;
    LAS unsigned* GL = (LAS unsigned*)lds;
    LAS float* RED = (LAS float*)(lds + LDS_X + 8192);
    LAS float* FIN = RED + 128;
    {   const int c8 = (tid & 127) * 8, rsub = tid >> 7;
        const int rbase = cont ? 30 : 0;
        u32x4 av[16];
#pragma unroll
        for (int ps = 0; ps < 16; ++ps) { const int rr = rbase + ps * 4 + rsub, t = t0 - 30 + rr; av[ps] = (u32x4){0u, 0u, 0u, 0u};
            if (rr < 62 && t >= 0) { const bf16_t* rp = PRb + (size_t)t * NPROJ; av[ps] = *(const u32x4*)(rp + C_G1 + c8); } }
        if (cont) { u32x4 mv[8];
#pragma unroll
            for (int it = 0; it < 8; ++it) { const int q = it * 512 + tid; if (q < 30 * 128) mv[it] = *(const LAS u32x4*)(GL + (32 + (q >> 7)) * 512 + (q & 127) * 4); }
            LDS_BARRIER();
#pragma unroll
            for (int it = 0; it < 8; ++it) { const int q = it * 512 + tid; if (q < 30 * 128) *(LAS u32x4*)(GL + (q >> 7) * 512 + (q & 127) * 4) = mv[it]; } }
#pragma unroll
        for (int ps = 0; ps < 16; ++ps) { const int rr = rbase + ps * 4 + rsub; if (rr < 62) *(LAS u32x4*)(GL + rr * 512 + (c8 >> 1)) = av[ps]; } }
    f32x2 wb[31];
#pragma unroll
    for (int k = 0; k < 31; ++k) wb[k] = *(const f32x2*)(p.conv_b_w + ((size_t)l * 31 + k) * D + c0);
    const f32x2 cbias = *(const f32x2*)(p.conv_b_bias + l * D + c0), lng = *(const f32x2*)(p.ln_g + l * D + c0), lnb = *(const f32x2*)(p.ln_b + l * D + c0);
    const f32x2 wa0 = *(const f32x2*)(p.conv_a_w + (l * 3 + 0) * D + c0), wa1 = *(const f32x2*)(p.conv_a_w + (l * 3 + 1) * D + c0), wa2 = *(const f32x2*)(p.conv_a_w + (l * 3 + 2) * D + c0);
    const f32x2 gb0 = *(const f32x2*)(p.gate_bias + l * 4 * D + c0), gb1 = *(const f32x2*)(p.gate_bias + l * 4 * D + D + c0);
    f32x2 u1 = {0.f, 0.f}, u2 = {0.f, 0.f}; unsigned pw[23];
#pragma unroll
    for (int i = 0; i < 15; ++i) pw[i] = 0u;
    if (t0 > 0) {
        const bf16_t* r2 = PRb + (size_t)(t0 - 2) * NPROJ + c0; const bf16_t* r1 = r2 + NPROJ;
        const unsigned q2 = *(const unsigned*)(r2 + C_HA), q1 = *(const unsigned*)(r1 + C_HA);
        u2 = (f32x2){bf_lo(q2), bf_hi(q2)}; u1 = (f32x2){bf_lo(q1), bf_hi(q1)};
#pragma unroll
        for (int i = 0; i < 15; ++i) pw[i] = *(const unsigned*)(PRb + (size_t)(t0 - 15 + i) * NPROJ + C_PIN + c0);
    }
    LDS_BARRIER();
    const int gsel = wid >> 1;
    float* outp = p.out;
    unsigned pcarry = 0u;
    if (t0 > 0) pcarry = *(const unsigned*)(PRb + (size_t)(t0 - 16) * NPROJ + C_PIN + c0);
    f32x2 psum = {0.f, 0.f};
    { const int wnd = 2 << gsel;
#pragma unroll
      for (int i = 1; i <= 16; ++i) { const unsigned q = (i <= 15) ? pw[15 - i] : pcarry; if (i <= wnd) { psum.x += bf_lo(q); psum.y += bf_hi(q); } } }
#pragma unroll 1
    for (int g = 0; g < 4; ++g) {
        const int tg = t0 + 8 * g;
        unsigned ha[8], ba[8], g0[8], g1[8];
#pragma unroll
        for (int j = 0; j < 8; ++j) { const bf16_t* rp = PRb + (size_t)(tg + j) * NPROJ + c0;
            ha[j] = *(const unsigned*)(rp + C_HA); pw[15 + j] = *(const unsigned*)(rp + C_PIN); }
        f32x2 z[8];
#pragma unroll
        for (int j = 0; j < 8; ++j) z[j] = cbias;
#pragma unroll
        for (int i = 0; i < 38; ++i) { const unsigned wv = GL[(8 * g + i) * 512 + tid]; const f32x2 x = {bf_lo(wv), bf_hi(wv)};
#pragma unroll
            for (int j = 0; j < 8; ++j) { const int k = i - j; if (k >= 0 && k < 31) z[j] += wb[k] * x; } }
        asm volatile("" ::: "memory");
#pragma unroll
        for (int j = 0; j < 8; ++j) { const bf16_t* rp = PRb + (size_t)(tg + j) * NPROJ + c0;
            ba[j] = *(const unsigned*)(rp + C_BA); g0[j] = *(const unsigned*)(rp + C_GATE); g1[j] = *(const unsigned*)(rp + C_GATE + D); }
#pragma unroll
        for (int j = 0; j < 8; ++j) { const float s1 = wave_sum_dpp(z[j].x + z[j].y), s2 = wave_sum_dpp(z[j].x * z[j].x + z[j].y * z[j].y);
            if (lane == 0) { RED[wid * 16 + j] = s1; RED[wid * 16 + 8 + j] = s2; } }
        LDS_BARRIER();
        if (tid < 16) { float s = 0.f;
#pragma unroll
            for (int w = 0; w < 8; ++w) s += RED[w * 16 + tid];
            FIN[tid] = s; }
        LDS_BARRIER();
#pragma unroll
        for (int j = 0; j < 8; ++j) {
            const int t = tg + j; const size_t row = (size_t)b * SEQ + t;
            const float mean = FIN[j] * (1.0f / D), var = FIN[8 + j] * (1.0f / D) - mean * mean, rstd = rsqrtf(var + EPS);
            f32x2 yb = (z[j] - mean) * rstd * lng + lnb; yb.x *= sigm(yb.x); yb.y *= sigm(yb.y);
            const f32x2 u0 = {bf_lo(ha[j]), bf_hi(ha[j])};
            f32x2 ya = wa0 * u2 + wa1 * u1 + wa2 * u0; ya.x *= bf_lo(ba[j]); ya.y *= bf_hi(ba[j]);
            u2 = u1; u1 = u0;
            const float e0 = sigm(bf_lo(g0[j]) + gb0.x) * ya.x + sigm(bf_lo(g1[j]) + gb1.x) * yb.x, e1 = sigm(bf_hi(g0[j]) + gb0.y) * ya.y + sigm(bf_hi(g1[j]) + gb1.y) * yb.y;
            *(unsigned*)(Eb + row * D + c0) = cvt_pk_bf16(e0, e1);
            { const unsigned pnw = pw[15 + j]; unsigned pold;
              { const unsigned p16 = (j >= 1) ? pw[j >= 1 ? j - 1 : 0] : pcarry; pold = gsel == 0 ? pw[13 + j] : (gsel == 1 ? pw[11 + j] : (gsel == 2 ? pw[7 + j] : p16)); }
              const f32x2 pn = {bf_lo(pnw), bf_hi(pnw)}, po = {bf_lo(pold), bf_hi(pold)};
              psum += pn - po;
              const int wnd = 2 << gsel; const float icnt = 1.0f / (float)(t + 1 < wnd ? t + 1 : wnd);
              *(unsigned*)(PL + row * D + c0) = cvt_pk_bf16(psum.x * icnt - pn.x, psum.y * icnt - pn.y); }
        }
        pcarry = pw[7];
#pragma unroll
        for (int i = 0; i < 15; ++i) pw[i] = pw[i + 8];
    }
    if (tt == 63) {
#pragma unroll
        for (int i = 0; i < 2; ++i) { const unsigned uu = *(const unsigned*)(PRb + (size_t)(SEQ - 2 + i) * NPROJ + c0 + C_HA);
            *(f32x2*)(outp + OUT_CAP + ((size_t)(l * NBATCH + b) * 2 + i) * D + c0) = (f32x2){bf_lo(uu), bf_hi(uu)}; }
#pragma unroll 5
        for (int i = 0; i < 15; ++i) { const unsigned pv = *(const unsigned*)(PRb + (size_t)(SEQ - 15 + i) * NPROJ + C_PIN + c0);
            *(f32x2*)(outp + OUT_PPP + ((size_t)(l * NBATCH + b) * 15 + i) * D + c0) = (f32x2){bf_lo(pv), bf_hi(pv)}; }
#pragma unroll 6
        for (int i = 0; i < 30; ++i) { const unsigned wv = GL[(32 + i) * 512 + tid];
            *(f32x2*)(outp + OUT_CBP + ((size_t)(l * NBATCH + b) * 30 + i) * D + c0) = (f32x2){bf_lo(wv), bf_hi(wv)}; }
    }
    LDS_BARRIER();
}
__device__ __forceinline__ void prepass_sample(const Params& p, int l, int sb, const int wid, LAS unsigned char* lds, const bf16_t* PROJ, bf16_t* Eb, bf16_t* PL) {
    const int lane = fresh_lane(), tid = wid * 64 + lane, c0 = 2 * tid;
    LAS float* RED = (LAS float*)(lds + LDS_X + 8192);
    const size_t row = (size_t)MP + sb; const bf16_t* rp = PROJ + row * NPROJ + c0; float* outp = p.out;
    const unsigned ha = *(const unsigned*)(rp + C_HA), ba = *(const unsigned*)(rp + C_BA), ca = *(const unsigned*)(rp + C_CA), q1 = *(const unsigned*)(rp + C_G1), q2 = *(const unsigned*)(rp + C_G2),
        pin = *(const unsigned*)(rp + C_PIN), g0 = *(const unsigned*)(rp + C_GATE), g1 = *(const unsigned*)(rp + C_GATE + D);
    const size_t ls = (size_t)l * NS + sb;
    const f32x2 sa0 = *(const f32x2*)(p.st_a + (ls * 2 + 0) * D + c0), sa1 = *(const f32x2*)(p.st_a + (ls * 2 + 1) * D + c0);
    const f32x2 wa0 = *(const f32x2*)(p.conv_a_w + (l * 3 + 0) * D + c0), wa1 = *(const f32x2*)(p.conv_a_w + (l * 3 + 1) * D + c0), wa2 = *(const f32x2*)(p.conv_a_w + (l * 3 + 2) * D + c0);
    const f32x2 u0 = {bf_lo(ca) * bf_lo(ha), bf_hi(ca) * bf_hi(ha)};
    f32x2 ya = wa0 * sa0 + wa1 * sa1 + wa2 * u0; ya.x *= bf_lo(ba); ya.y *= bf_hi(ba);
    *(f32x2*)(outp + OUT_CAS + (ls * 2 + 0) * D + c0) = sa1; *(f32x2*)(outp + OUT_CAS + (ls * 2 + 1) * D + c0) = u0;
    const f32x2 glu = {bf_lo(q1) * sigm(bf_lo(q2)), bf_hi(q1) * sigm(bf_hi(q2))};
    f32x2 z = *(const f32x2*)(p.conv_b_bias + l * D + c0) + *(const f32x2*)(p.conv_b_w + ((size_t)l * 31 + 30) * D + c0) * glu;
#pragma unroll 10
    for (int k = 0; k < 30; ++k) { const f32x2 s = *(const f32x2*)(p.st_b + (ls * 30 + k) * D + c0); z += *(const f32x2*)(p.conv_b_w + ((size_t)l * 31 + k) * D + c0) * s;
        if (k >= 1) *(f32x2*)(outp + OUT_CBS + (ls * 30 + k - 1) * D + c0) = s; }
    *(f32x2*)(outp + OUT_CBS + (ls * 30 + 29) * D + c0) = glu;
    const float s1 = wave_sum_dpp(z.x + z.y), s2 = wave_sum_dpp(z.x * z.x + z.y * z.y);
    if (lane == 0) { RED[wid * 2] = s1; RED[wid * 2 + 1] = s2; }
    LDS_BARRIER();
    float S1 = 0.f, S2 = 0.f;
#pragma unroll
    for (int w = 0; w < 8; ++w) { S1 += RED[w * 2]; S2 += RED[w * 2 + 1]; }
    const float mean = S1 * (1.0f / D), var = S2 * (1.0f / D) - mean * mean, rstd = rsqrtf(var + EPS);
    f32x2 yb = (z - mean) * rstd * *(const f32x2*)(p.ln_g + l * D + c0) + *(const f32x2*)(p.ln_b + l * D + c0); yb.x *= sigm(yb.x); yb.y *= sigm(yb.y);
    const f32x2 gb0 = *(const f32x2*)(p.gate_bias + l * 4 * D + c0), gb1 = *(const f32x2*)(p.gate_bias + l * 4 * D + D + c0);
    const float e0 = sigm(bf_lo(g0) + gb0.x) * ya.x + sigm(bf_lo(g1) + gb1.x) * yb.x, e1 = sigm(bf_hi(g0) + gb0.y) * ya.y + sigm(bf_hi(g1) + gb1.y) * yb.y;
    *(unsigned*)(Eb + row * D + c0) = cvt_pk_bf16(e0, e1);
    const int gsel = wid >> 1, wnd = 2 << gsel; const f32x2 pn = {bf_lo(pin), bf_hi(pin)}; f32x2 s = pn;
#pragma unroll
    for (int i = 0; i < 15; ++i) { const f32x2 sp = *(const f32x2*)(p.st_p + (ls * 15 + i) * D + c0); if (i >= 16 - wnd) s += sp;
        if (i >= 1) *(f32x2*)(outp + OUT_PPS + (ls * 15 + i - 1) * D + c0) = sp; }
    *(f32x2*)(outp + OUT_PPS + (ls * 15 + 14) * D + c0) = pn;
    const float iw = 1.0f / (float)wnd;
    *(unsigned*)(PL + row * D + c0) = cvt_pk_bf16(s.x * iw - pn.x, s.y * iw - pn.y);
    LDS_BARRIER();
}
__device__ __forceinline__ void sample_attn(const Params& p, int l, int item, const int wid, LAS unsigned char* lds, const bf16_t* PROJ, float* YMS) {
    const int lane = fresh_lane(), tid = wid * 64 + lane, sb = item >> 2, h = item & 3;
    LAS float* OB = (LAS float*)lds;
    LAS float* MS = OB + 2048;
    const u32x2 qw = *(const u32x2*)(PROJ + ((size_t)MP + sb) * NPROJ + C_Q + h * 256 + 4 * lane);
    const float sc = 0.0625f * 1.44269504f;
    const f32x4 q = {bf_lo(qw.x) * sc, bf_hi(qw.x) * sc, bf_lo(qw.y) * sc, bf_hi(qw.y) * sc};
    const size_t base = ((((size_t)l * NS + sb) * NMEM + wid * 32) * 4 + h) * 256 + 4 * lane;
    const float* Kp = p.cache_k + base; const float* Vp = p.cache_v + base;
    f32x4 kv[32]; float s[32];
#pragma unroll
    for (int i = 0; i < 32; ++i) kv[i] = __builtin_nontemporal_load((const f32x4*)(Kp + (size_t)i * 1024));
#pragma unroll
    for (int i = 0; i < 32; ++i) s[i] = wave_sum((kv[i].x * q.x + kv[i].y * q.y) + (kv[i].z * q.z + kv[i].w * q.w));
#pragma unroll
    for (int i = 0; i < 32; ++i) kv[i] = __builtin_nontemporal_load((const f32x4*)(Vp + (size_t)i * 1024));
    float mx = s[0];
#pragma unroll
    for (int i = 1; i < 32; ++i) mx = fmaxf(mx, s[i]);
    float sum = 0.f; f32x4 o = {0.f, 0.f, 0.f, 0.f};
#pragma unroll
    for (int i = 0; i < 32; ++i) { const float pr = __builtin_amdgcn_exp2f(s[i] - mx); sum += pr; o += kv[i] * pr; }
    *(LAS f32x4*)(OB + wid * 256 + 4 * lane) = o;
    if (lane == 0) { MS[wid] = mx; MS[8 + wid] = sum; }
    LDS_BARRIER();
    if (tid < 256) { float gm = MS[0];
#pragma unroll
        for (int w = 1; w < 8; ++w) gm = fmaxf(gm, MS[w]);
        float tot = 0.f, acc = 0.f;
#pragma unroll
        for (int w = 0; w < 8; ++w) { const float f = __builtin_amdgcn_exp2f(MS[w] - gm); tot += MS[8 + w] * f; acc += OB[w * 256 + tid] * f; }
        YMS[(size_t)sb * D + h * 256 + tid] = acc / tot; }
    LDS_BARRIER();
}

__global__ void __launch_bounds__(512, 2) mega_fwd(Params p) {
    extern __shared__ __attribute__((aligned(16))) unsigned char lds_raw[];
    LAS unsigned char* lds = (LAS unsigned char*)lds_raw;
    const int wave = __builtin_amdgcn_readfirstlane(threadIdx.x >> 6);
    const int G = gridDim.x, bx = blockIdx.x;
    unsigned char* ws = p.ws;
#define PHASE_BEGIN() size_t wsz = 0; int bxo = bx, Go = G, lo = l, wvo = wave; unsigned ldsv = 0u; asm volatile("" : "+s"(wsz), "+s"(bxo), "+s"(Go), "+s"(lo), "+s"(ldsv), "+s"(wvo)); \
    unsigned char* wso = ws + wsz;     \
    LAS unsigned char* ldso = lds + ldsv; \
    bf16_t* WIN = (bf16_t*)(wso + WS_WIN); bf16_t* WKV = (bf16_t*)(wso + WS_WKV); bf16_t* WO = (bf16_t*)(wso + WS_WO); bf16_t* W1 = (bf16_t*)(wso + WS_W1); bf16_t* W2 = (bf16_t*)(wso + WS_W2); \
    bf16_t* WP = (bf16_t*)(wso + WS_WP); bf16_t* XB = (bf16_t*)(wso + WS_XB); bf16_t* MEMB = (bf16_t*)(wso + WS_MEMB); bf16_t* KB = (bf16_t*)(wso + WS_KB); bf16_t* VT = (bf16_t*)(wso + WS_VT); \
    bf16_t* Eb = (bf16_t*)(wso + WS_E); bf16_t* PL = (bf16_t*)(wso + WS_PL); bf16_t* PP = (bf16_t*)(wso + WS_PP); bf16_t* MG = (bf16_t*)(wso + WS_MG); float* X = (float*)(wso + WS_X); \
    float* YMS = (float*)(wso + WS_YMS); float* RSS = (float*)(wso + WS_RSS); float* RSM = (float*)(wso + WS_RSM); float* RSQ = (float*)(wso + WS_RSQ); \
    float* rsqA = RSQ + (2 * lo) * 4096; float* rsqB = RSQ + (2 * lo + 1) * 4096; float* rsqN = RSQ + ((2 * lo + 2) & 3) * 4096; (void)rsqA; (void)rsqB; (void)rsqN; bf16_t* PROJ = (bf16_t*)(wso + WS_PROJ); bf16_t* HB = PROJ; \
    float* rssA = RSS + (size_t)(2 * lo) * MPAD * 16; float* rssB = RSS + (size_t)(2 * lo + 1) * MPAD * 16; float* rssN = RSS + (size_t)((2 * lo + 2) & 3) * MPAD * 16; \
    (void)WIN; (void)WKV; (void)WO; (void)W1; (void)W2; (void)WP; (void)XB; (void)MEMB; (void)KB; (void)VT; (void)Eb; (void)PL; (void)PP; (void)MG; (void)X; (void)YMS; (void)RSS; (void)RSM; (void)PROJ; (void)HB; (void)rssA; (void)rssB; (void)rssN;
    cg::grid_group grid = cg::this_grid();
#if USE_CG_SYNC
#define GRID_BAR() grid.sync()
#else
    volatile LAS unsigned* bst = (volatile LAS unsigned*)(lds + LDS_X + 12288);
    if (threadIdx.x < 2) bst[threadIdx.x] = 0u;
    if (bx == 0) for (int i = threadIdx.x; i < XCD_BAR_WORDS; i += 512) __hip_atomic_store((unsigned*)(ws + WS_CTL) + i, 0u, __ATOMIC_RELAXED, __HIP_MEMORY_SCOPE_AGENT);
    __syncthreads();
    XcdBarrier bar; bar.bar = (unsigned*)(ws + WS_CTL); bar.x = 0; bar.st = bst;
#define GRID_BAR() xcd_barrier(bar)
#endif

    {
        const int l = 0; PHASE_BEGIN();
        const int lane = fresh_lane();
        LAS float* scr = (LAS float*)(ldso + wvo * 8448);
        const int gw = bxo * 8 + wvo, NGW = Go * 8;
        constexpr int I_IN = 16 * (NPROJ / 32), I_KV = 16 * 64, I_O = 16 * 32, I_1 = 16 * 128, I_2 = 64 * 32, I_P = 4 * 8, PER_L = I_IN + I_KV + I_O + I_1 + I_2 + 4 * I_P;
        for (int rep = 0; rep < REP_P0; ++rep)
        for (int it = gw; it < DEPTH * PER_L; it += NGW) {
            const int l = it / PER_L; int r = it % PER_L;
            if (r < I_IN) { transpose_item(p.w_in + (size_t)l * D * NPROJ, D, NPROJ, WIN + (size_t)l * NPROJ * D, p.norm_mix + l * D, nullptr, scr, r, lane, true); continue; } r -= I_IN;
            if (r < I_KV) { transpose_item(p.w_kv + (size_t)l * D * 2048, D, 2048, WKV + (size_t)l * 2048 * D, p.norm_mem + l * D, nullptr, scr, r, lane); continue; } r -= I_KV;
            if (r < I_O) { transpose_item(p.w_o + (size_t)l * D * D, D, D, WO + (size_t)l * D * D, nullptr, nullptr, scr, r, lane); continue; } r -= I_O;
            if (r < I_1) { transpose_item(p.w_ff1 + (size_t)l * D * DFF, D, DFF, W1 + (size_t)l * DFF * D, p.norm_ffn + l * D, nullptr, scr, r, lane); continue; } r -= I_1;
            if (r < I_2) { transpose_item(p.w_ff2 + (size_t)l * DFF * D, DFF, D, W2 + (size_t)l * D * DFF, nullptr, nullptr, scr, r, lane); continue; } r -= I_2;
            { const int g = r / I_P; transpose_item(p.pool_w + ((size_t)l * 4 + g) * 65536, 256, 256, WP + ((size_t)l * 4 + g) * 65536, nullptr, p.pool_scale + l * D + g * 256, scr, r % I_P, lane); }
        }
        for (int rep = 0; rep < REP_P0; ++rep)
        for (int m = gw; m < MPAD; m += NGW) {
            const float* src = m < MP ? p.x_prompt + (size_t)m * D : (m < MROWS ? p.x_sample + (size_t)(m - MP) * D : nullptr);
            const float ss = row_to_bf16(src, XB + (size_t)m * D, lane);
            if (lane < 16) RSS[(size_t)m * 16 + lane] = lane == 0 ? ss : 0.f;
            if (m >= MP && m < MROWS && lane < 32) RSQ[(m - MP) * 32 + lane] = lane == 0 ? ss : 0.f;
        }
        for (int m = gw; m < 2048; m += NGW) { const float ss = row_to_bf16(p.mem_prompt + (size_t)m * D, MEMB + (size_t)m * D, lane); if (lane == 0) RSM[m] = ss; }
    }
    grid.sync();
#if !USE_CG_SYNC
    bar = xcd_barrier_post((unsigned*)(ws + WS_CTL), bst);
#endif

    {
        const int l = 0; PHASE_BEGIN();
        ProbStd P{(const char*)MEMB, (const char*)WKV, D, D, D}; pg8::StaticOrder S; S.init(8, 16, Go, bxo);
        EpiKV E{p.out, KB, VT, RSM};
        pg8::gemm_phase(ldso, P, S, E, wvo);
        SProbStd SP{XB + (size_t)MP * D, WIN, D, D}; SEpiProj SE{PROJ, RSQ};
        constexpr int NT = 4 * (NPROJ / 32), NT_HI = 1024;
        if (Go == 256) { if (bxo >= 128) skinny_gemm<4>(ldso, SP, SE, NT_HI, bxo - 128, 128, wvo, 0); else skinny_gemm<4>(ldso, SP, SE, NT - NT_HI, bxo, 128, wvo, NT_HI); }
        else skinny_gemm<4>(ldso, SP, SE, NT, bxo, Go, wvo);
    }
    GRID_BAR();
#pragma unroll 1
    for (int l = 0; l < DEPTH; ++l) {
        {
            PHASE_BEGIN();
            const int flip = (bxo >> 3) & 1;
            ProbStd P{(const char*)XB, (const char*)(WIN + (size_t)lo * NPROJ * D), D, D, D}; pg8::StaticOrder S; S.init(MP / 256, NPROJ / 256, Go, bxo);
            EpiProj E{PROJ, NPROJ, rssA};
#pragma unroll 1
            for (int step = 0; step < 3; ++step) {
                if (step == 1) pg8::gemm_phase(ldso, P, S, E, wvo);
                else if ((step == 0) == (flip != 0)) {
                    for (int sb = bxo; sb < NS; sb += Go) prepass_sample(p, lo, sb, wvo, ldso, PROJ, Eb, PL);
                    for (int it = bxo; it < NS * 4; it += Go) sample_attn(p, lo, it, wvo, ldso, PROJ, YMS);
                }
            }
        }
        GRID_BAR();
        {
            PHASE_BEGIN();
            for (int T2 = bxo; T2 < 256; T2 += Go)
#pragma unroll 1
                for (int h = 0; h < 2; ++h) prepass_prompt(p, lo, 2 * T2 + h, h, wvo, ldso, PROJ, Eb, PL);
            ProbS P{(const char*)PROJ, (const char*)(KB + (size_t)lo * 2048 * D), NPROJ, D, 256}; OrderS S{Go, bxo};
            EpiS E{PP};
            pg8::gemm_phase(ldso, P, S, E, wvo);
            SProbPool SP{PL + (size_t)MP * D, WP + (size_t)lo * 4 * 65536, D, 256}; SEpiMerge SE{Eb, MG, PROJ, p.gate_bias + lo * 4 * D, YMS};
            skinny_gemm<1>(ldso, SP, SE, 4 * (D / 32), bxo, Go, wvo);
        }
        GRID_BAR();
        {
            PHASE_BEGIN();
            ProbMerge P{(const char*)PL, (const char*)(WP + (size_t)lo * 4 * 65536), (long)((const char*)PP - (const char*)PL), (long)((const char*)(VT + (size_t)lo * 32 * 65536) - (const char*)(WP + (size_t)lo * 4 * 65536)), D, 256, 256}; OrderMerge S{Go, bxo};
            EpiMerge E{Eb, MG, PROJ, p.gate_bias + lo * 4 * D};
            pg8::gemm_phase(ldso, P, S, E, wvo);
            SProbStd SP{MG + (size_t)MP * D, WO + (size_t)lo * D * D, D, D}; SEpiRes SE{lo == 0 ? p.x_sample : nullptr, XB, rsqB};
            skinny_gemm<4>(ldso, SP, SE, 4 * (D / 32), bxo, Go, wvo);
        }
        GRID_BAR();
        {
            PHASE_BEGIN();
            ProbStd P{(const char*)MG, (const char*)(WO + (size_t)lo * D * D), D, D, D}; pg8::StaticOrder S; S.init(MP / 256, 4, Go, bxo);
            EpiRes E{lo == 0 ? p.x_prompt : nullptr, XB, rssB};
            pg8::gemm_phase(ldso, P, S, E, wvo);
            SProbStd SP{XB + (size_t)MP * D, W1 + (size_t)lo * DFF * D, D, D}; SEpiFF1 SE{HB, rsqB};
            skinny_gemm<4>(ldso, SP, SE, 4 * (DFF / 32), bxo, Go, wvo);
        }
        GRID_BAR();
        {
            PHASE_BEGIN();
            ProbStd P{(const char*)XB, (const char*)(W1 + (size_t)lo * DFF * D), D, D, D}; pg8::StaticOrder S; S.init(MP / 256, DFF / 256, Go, bxo);
            EpiFF1 E{HB, rssB};
            pg8::gemm_phase(ldso, P, S, E, wvo);
            SProbStd SP{HB + (size_t)MP * DFF, W2 + (size_t)lo * D * DFF, DFF, DFF}; SEpiRes SE{nullptr, XB, rsqN};
            skinny_gemm<16>(ldso, SP, SE, 4 * (D / 32), bxo, Go, wvo);
        }
        GRID_BAR();
        {
            PHASE_BEGIN();
            ProbStd P{(const char*)HB, (const char*)(W2 + (size_t)lo * D * DFF), DFF, DFF, DFF}; pg8::StaticOrder S; S.init(MP / 256, 4, Go, bxo);
            EpiRes E{nullptr, XB, rssN};
            pg8::gemm_phase(ldso, P, S, E, wvo);
            if (lo + 1 < DEPTH) { SProbStd SP{XB + (size_t)MP * D, WIN + (size_t)(lo + 1) * NPROJ * D, D, D}; SEpiProj SE{PROJ, rsqN};
                skinny_gemm<4>(ldso, SP, SE, 4 * (NPROJ / 32), bxo, Go, wvo); }
        }
        GRID_BAR();
    }
    {
        const int l = 0; PHASE_BEGIN();
        const int lane = fresh_lane();
        const int gw = bxo * 8 + wvo, NGW = Go * 8;
        for (int m = gw; m < MROWS; m += NGW) {
            const u32x2* xr = (const u32x2*)(XB + (size_t)m * D) + lane; f32x4 v[4]; float s = 0.f;
#pragma unroll
            for (int j = 0; j < 4; ++j) { const u32x2 q = xr[64 * j]; v[j] = (f32x4){bf_lo(q.x), bf_hi(q.x), bf_lo(q.y), bf_hi(q.y)}; s += (v[j].x * v[j].x + v[j].y * v[j].y) + (v[j].z * v[j].z + v[j].w * v[j].w); }
            const float rstd = rsqrtf(wave_sum(s) * (1.0f / D) + EPS);
            f32x4* o = (f32x4*)(p.out + (size_t)m * D) + lane;
#pragma unroll
            for (int j = 0; j < 4; ++j) o[64 * j] = v[j] * rstd * *((const f32x4*)p.norm_final + lane + 64 * j);
        }
    }
}

extern "C" void kernel_launch(void* const* d_in, const int* in_sizes, int n_in, void* d_out, int out_size, void* d_ws, size_t ws_size, hipStream_t stream) {
    static int grid = 0;
    if (grid == 0) {
        if (n_in != 25 || (size_t)out_size != OUT_END || ws_size < WS_END) { fprintf(stderr, "kernel_launch: unexpected shapes (n_in %d out %d ws %zu need %zu)\n", n_in, out_size, ws_size, (size_t)WS_END); grid = -1; return; }
        int dev = 0, cus = 0, per_cu = 0;
        hipGetDevice(&dev); hipDeviceGetAttribute(&cus, hipDeviceAttributeMultiprocessorCount, dev);
        if (hipFuncSetAttribute((const void*)mega_fwd, hipFuncAttributeMaxDynamicSharedMemorySize, LDS_BYTES) != hipSuccess) { fprintf(stderr, "kernel_launch: hipFuncSetAttribute failed\n"); grid = -1; return; }
        if (hipOccupancyMaxActiveBlocksPerMultiprocessor(&per_cu, (const void*)mega_fwd, 512, LDS_BYTES) != hipSuccess || per_cu < 1) { fprintf(stderr, "kernel_launch: occupancy query gave %d\n", per_cu); per_cu = 1; }
        (void)hipGetLastError();
        grid = cus * per_cu;
    }
    if (grid < 0) return;
    Params p{};
    const float** pf = (const float**)&p;
    for (int i = 0; i < 25; ++i) pf[i] = (const float*)d_in[i];
    p.out = (float*)d_out; p.ws = (unsigned char*)d_ws;
    void* args[] = {&p};
    hipError_t e = hipLaunchCooperativeKernel((const void*)mega_fwd, dim3(grid), dim3(512), args, LDS_BYTES, stream);
    if (e != hipSuccess) fprintf(stderr, "kernel_launch: cooperative launch failed: %s (grid %d)\n", hipGetErrorString(e), grid);
}
```
